# Optimizing an MI355X kernel written in HIP

```python
import math
import jax, jax.numpy as jnp
from jax import lax
import numpy as np

D_MODEL = 1024
BATCH = 16
SEQ = 2048
DEPTH = 1
DEC_BATCH = 8
DEC_SEQ = 32
PAST_LEN = 1024

CHUNK = 64
PLE_DIM = 256
EPS = 1e-6
NEG_INF = -1e30
N_HEADS_A = 16
HEAD_DIM_A = 64
ATT_WIDTH = N_HEADS_A * HEAD_DIM_A
LEFT_CHUNKS = 8
ATT_PAST = LEFT_CHUNKS * CHUNK
BAND = ATT_PAST + CHUNK
REL_CLIP = 128
SSM_EXPAND = 2
D_INNER = SSM_EXPAND * D_MODEL
SSM_HEAD_DIM = 64
N_HEADS_S = D_INNER // SSM_HEAD_DIM
N_GROUPS = 4
HEADS_PER_GROUP = N_HEADS_S // N_GROUPS
D_STATE = 128
SSM_CONV = 4
CONV_DIM = D_INNER + 2 * N_GROUPS * D_STATE
D_FF = 3 * D_MODEL
FFN_CONV = 3
IN_SIZES = (ATT_WIDTH, ATT_WIDTH, ATT_WIDTH, D_INNER, CONV_DIM, N_HEADS_S, 2 * D_MODEL)
N_IN = 3 * ATT_WIDTH + D_INNER + CONV_DIM + N_HEADS_S + 2 * D_MODEL

kernel_name = 'hybrid_streaming_band_attn_ssd_convffn_step'


def rmsnorm(x, g):
    xf = x.astype(jnp.float32)
    y = xf * lax.rsqrt(jnp.mean(xf * xf, axis=-1, keepdims=True) + EPS)
    return (y * g.astype(jnp.float32)).astype(x.dtype)


def causal_dwconv(x_ext, w, b):
    width = w.shape[0]
    l = x_ext.shape[1] - width + 1
    out = b
    for i in range(width):
        out = out + x_ext[:, i:i + l] * w[i]
    return out


def rel_bias_lookup(table, rel):
    return table[:, jnp.clip(rel, -REL_CLIP, REL_CLIP) + REL_CLIP].astype(jnp.float32)


def attend(q, k, v, bias):
    logits = jnp.einsum('bihd,bjhd->bhij', q.astype(jnp.float32), k.astype(jnp.float32)) * (HEAD_DIM_A ** -0.5)
    probs = jax.nn.softmax(logits + bias[None], axis=-1)
    return jnp.einsum('bhij,bjhd->bihd', probs, v.astype(jnp.float32))


def band_attention(q, k, v, table):
    b, l = q.shape[:2]
    nc = l // CHUNK
    pad = ((0, 0), (ATT_PAST, 0), (0, 0), (0, 0))
    kp = jnp.pad(k, pad)
    vp = jnp.pad(v, pad)
    qc = q.reshape(b, nc, CHUNK, N_HEADS_A, HEAD_DIM_A)
    rel = (ATT_PAST + jnp.arange(CHUNK))[:, None] - jnp.arange(BAND)[None, :]
    bias = rel_bias_lookup(table, rel)

    def one_chunk(c):
        qi = lax.dynamic_index_in_dim(qc, c, axis=1, keepdims=False)
        kb = lax.dynamic_slice_in_dim(kp, c * CHUNK, BAND, axis=1)
        vb = lax.dynamic_slice_in_dim(vp, c * CHUNK, BAND, axis=1)
        valid = (c * CHUNK - ATT_PAST + jnp.arange(BAND)) >= 0
        return attend(qi, kb, vb, jnp.where(valid[None, None, :], bias, NEG_INF))

    out = lax.map(one_chunk, jnp.arange(nc))
    return jnp.moveaxis(out, 0, 1).reshape(b, l, ATT_WIDTH)


def cached_attention(q, k, v, ck, cv, table):
    b, t = q.shape[:2]
    lc = ck.shape[1]
    kk = jnp.concatenate([ck.astype(k.dtype), k], axis=1)
    vv = jnp.concatenate([cv.astype(v.dtype), v], axis=1)
    rel = (lc + jnp.arange(t))[:, None] - jnp.arange(lc + t)[None, :]
    out = attend(q, kk, vv, rel_bias_lookup(table, rel))
    return out.reshape(b, t, ATT_WIDTH)


def ssd(xs, dt, a_log, bm, cm, h0):
    b, l = xs.shape[:2]
    q = min(CHUNK, l)
    nc = l // q
    a_neg = -jnp.exp(a_log.astype(jnp.float32)).reshape(N_GROUPS, HEADS_PER_GROUP)
    xg = xs.reshape(b, l, N_GROUPS, HEADS_PER_GROUP, SSM_HEAD_DIM)
    dtg = dt.reshape(b, l, N_GROUPS, HEADS_PER_GROUP)
    ag = dtg * a_neg
    tri = (jnp.arange(q)[:, None] >= jnp.arange(q)[None, :])[None, :, :, None, None]

    def chunks(t):
        return jnp.moveaxis(t.reshape((b, nc, q) + t.shape[2:]), 1, 0)

    def step(hc, inp):
        xc, dtc, ac, bc, cc = inp
        acs = jnp.cumsum(ac, axis=1)
        seg = acs[:, :, None] - acs[:, None, :]
        decay = jnp.where(tri, jnp.exp(jnp.where(tri, seg, 0.0)), 0.0)
        cb = jnp.einsum('bign,bjgn->bijg', cc, bc)
        dx = dtc[..., None] * xc
        y = jnp.einsum('bijg,bijgr,bjgrp->bigrp', cb, decay, dx)
        y = y + jnp.einsum('bign,bgrpn->bigrp', cc, hc) * jnp.exp(acs)[..., None]
        last = acs[:, -1]
        wj = jnp.exp(last[:, None] - acs)[..., None] * dx
        h_new = hc * jnp.exp(last)[..., None, None] + jnp.einsum('bjgn,bjgrp->bgrpn', bc, wj)
        return h_new, y

    h_init = h0.reshape(b, N_GROUPS, HEADS_PER_GROUP, SSM_HEAD_DIM, D_STATE)
    h_fin, ys = lax.scan(step, h_init, (chunks(xg), chunks(dtg), chunks(ag), chunks(bm), chunks(cm)))
    y = jnp.moveaxis(ys, 0, 1).reshape(b, l, N_HEADS_S, SSM_HEAD_DIM)
    return y, h_fin.reshape(b, N_HEADS_S, SSM_HEAD_DIM, D_STATE)


def layer(x, pe, kv_cache, ssm_ctx, h0, ffn_ctx, prm):
    (g_mix, w_in, b_gate, g_q, g_k, rel_bias, conv_ssm_w, conv_ssm_b, dt_bias, a_log, d_skip, g_ssm,
     w_proj_a, w_proj_b, w_out, g_ffn, w_up, ffn_conv_w, ffn_conv_b, w_down, g_ple, w_ple_gate, w_ple) = prm
    b, l, _ = x.shape
    h = rmsnorm(x, g_mix)
    proj = h @ w_in
    split_at = []
    acc = 0
    for s in IN_SIZES[:-1]:
        acc += s
        split_at.append(acc)
    q, k, v, z, xbc, dt_raw, gates = jnp.split(proj, split_at, axis=-1)

    q = rmsnorm(q.reshape(b, l, N_HEADS_A, HEAD_DIM_A), g_q)
    k = rmsnorm(k.reshape(b, l, N_HEADS_A, HEAD_DIM_A), g_k)
    v = v.reshape(b, l, N_HEADS_A, HEAD_DIM_A)
    if kv_cache is None:
        ya = band_attention(q, k, v, rel_bias)
        new_k, new_v = k[:, -ATT_PAST:], v[:, -ATT_PAST:]
    else:
        ya = cached_attention(q, k, v, kv_cache[0], kv_cache[1], rel_bias)
        new_k, new_v = k, v
    ya = ya.astype(x.dtype)

    xbc_ext = jnp.concatenate([ssm_ctx.astype(xbc.dtype), xbc], axis=1)
    new_ssm_ctx = xbc_ext[:, -(SSM_CONV - 1):]
    xbc_c = jax.nn.silu(causal_dwconv(xbc_ext, conv_ssm_w, conv_ssm_b)).astype(jnp.float32)
    xs, bm, cm = jnp.split(xbc_c, [D_INNER, D_INNER + N_GROUPS * D_STATE], axis=-1)
    xs = xs.reshape(b, l, N_HEADS_S, SSM_HEAD_DIM)
    dt = jax.nn.softplus(dt_raw.astype(jnp.float32) + dt_bias.astype(jnp.float32))
    y, h_fin = ssd(xs, dt, a_log, bm.reshape(b, l, N_GROUPS, D_STATE),
                   cm.reshape(b, l, N_GROUPS, D_STATE), h0.astype(jnp.float32))
    y = (y + d_skip.astype(jnp.float32)[:, None] * xs).reshape(b, l, D_INNER)
    yb = rmsnorm(y * jax.nn.silu(z.astype(jnp.float32)), g_ssm).astype(x.dtype)

    gate_a, gate_b = jnp.split(jax.nn.sigmoid(gates + b_gate), 2, axis=-1)
    x = x + (gate_a * (ya @ w_proj_a) + gate_b * (yb @ w_proj_b)) @ w_out

    u = rmsnorm(x, g_ffn) @ w_up
    u_ext = jnp.concatenate([ffn_ctx.astype(u.dtype), u], axis=1)
    new_ffn_ctx = u_ext[:, -(FFN_CONV - 1):]
    ug, uv = jnp.split(causal_dwconv(u_ext, ffn_conv_w, ffn_conv_b), 2, axis=-1)
    x = x + (jax.nn.gelu(ug, approximate=True) * uv) @ w_down

    x = x + jax.nn.sigmoid(rmsnorm(x, g_ple) @ w_ple_gate) * (pe.astype(x.dtype) @ w_ple)
    return x, (new_k, new_v, h_fin, new_ssm_ctx, new_ffn_ctx)


def setup_inputs(seed: int = 0) -> dict:
    key = jax.random.key(seed)
    ks = jax.random.split(key, 40)
    f32 = jnp.float32

    def nrm(k, shape, s):
        return s * jax.random.normal(k, shape, f32)

    l_att = min(ATT_PAST, PAST_LEN)
    dt0 = jnp.exp(jax.random.uniform(ks[20], (DEPTH, N_HEADS_S), f32, math.log(1e-3), math.log(1e-1)))
    dt_bias = dt0 + jnp.log(-jnp.expm1(-dt0))
    a_log = jnp.log(jax.random.uniform(ks[21], (DEPTH, N_HEADS_S), f32, 1.0, 16.0))
    return {
        'x_prompt': nrm(ks[0], (BATCH, SEQ, D_MODEL), 1.0),
        'x_sample': nrm(ks[1], (DEC_BATCH, DEC_SEQ, D_MODEL), 1.0),
        'cache_k': nrm(ks[2], (DEPTH, DEC_BATCH, l_att, N_HEADS_A, HEAD_DIM_A), 1.0),
        'cache_v': nrm(ks[3], (DEPTH, DEC_BATCH, l_att, N_HEADS_A, HEAD_DIM_A), 1.0),
        'state_ssm': nrm(ks[4], (DEPTH, DEC_BATCH, N_HEADS_S, SSM_HEAD_DIM, D_STATE), 0.1),
        'state_conv_ssm': nrm(ks[5], (DEPTH, DEC_BATCH, SSM_CONV - 1, CONV_DIM), 1.0),
        'state_conv_ffn': nrm(ks[6], (DEPTH, DEC_BATCH, FFN_CONV - 1, 2 * D_FF), 1.0),
        'p_prompt': nrm(ks[7], (DEPTH, BATCH, SEQ, PLE_DIM), 1.0),
        'p_sample': nrm(ks[8], (DEPTH, DEC_BATCH, DEC_SEQ, PLE_DIM), 1.0),
        'g_mix': 1.0 + nrm(ks[9], (DEPTH, D_MODEL), 0.05),
        'w_in': nrm(ks[10], (DEPTH, D_MODEL, N_IN), D_MODEL ** -0.5),
        'b_gate': nrm(ks[11], (DEPTH, 2 * D_MODEL), 0.01),
        'g_q': 1.0 + nrm(ks[12], (DEPTH, HEAD_DIM_A), 0.05),
        'g_k': 1.0 + nrm(ks[13], (DEPTH, HEAD_DIM_A), 0.05),
        'rel_bias': nrm(ks[14], (DEPTH, N_HEADS_A, 2 * REL_CLIP + 1), 0.1),
        'conv_ssm_w': nrm(ks[15], (DEPTH, SSM_CONV, CONV_DIM), SSM_CONV ** -0.5),
        'conv_ssm_b': nrm(ks[16], (DEPTH, CONV_DIM), 0.01),
        'dt_bias': dt_bias,
        'a_log': a_log,
        'd_skip': 1.0 + nrm(ks[17], (DEPTH, N_HEADS_S), 0.1),
        'g_ssm': 1.0 + nrm(ks[18], (DEPTH, D_INNER), 0.05),
        'w_proj_a': nrm(ks[19], (DEPTH, ATT_WIDTH, D_MODEL), ATT_WIDTH ** -0.5),
        'w_proj_b': nrm(ks[22], (DEPTH, D_INNER, D_MODEL), D_INNER ** -0.5),
        'w_out': nrm(ks[23], (DEPTH, D_MODEL, D_MODEL), D_MODEL ** -0.5),
        'g_ffn': 1.0 + nrm(ks[24], (DEPTH, D_MODEL), 0.05),
        'w_up': nrm(ks[25], (DEPTH, D_MODEL, 2 * D_FF), D_MODEL ** -0.5),
        'ffn_conv_w': nrm(ks[26], (DEPTH, FFN_CONV, 2 * D_FF), FFN_CONV ** -0.5),
        'ffn_conv_b': nrm(ks[27], (DEPTH, 2 * D_FF), 0.01),
        'w_down': nrm(ks[28], (DEPTH, D_FF, D_MODEL), D_FF ** -0.5),
        'g_ple': 1.0 + nrm(ks[29], (DEPTH, D_MODEL), 0.05),
        'w_ple_gate': nrm(ks[30], (DEPTH, D_MODEL, D_MODEL), D_MODEL ** -0.5),
        'w_ple': nrm(ks[31], (DEPTH, PLE_DIM, D_MODEL), PLE_DIM ** -0.5),
    }


def reference(x_prompt, x_sample, cache_k, cache_v, state_ssm, state_conv_ssm, state_conv_ffn,
              p_prompt, p_sample, g_mix, w_in, b_gate, g_q, g_k, rel_bias, conv_ssm_w, conv_ssm_b,
              dt_bias, a_log, d_skip, g_ssm, w_proj_a, w_proj_b, w_out, g_ffn, w_up, ffn_conv_w,
              ffn_conv_b, w_down, g_ple, w_ple_gate, w_ple):
    bp = x_prompt.shape[0]
    yp, ys = x_prompt, x_sample
    sp, ss = [], []
    for i in range(DEPTH):
        prm = (g_mix[i], w_in[i], b_gate[i], g_q[i], g_k[i], rel_bias[i], conv_ssm_w[i], conv_ssm_b[i],
               dt_bias[i], a_log[i], d_skip[i], g_ssm[i], w_proj_a[i], w_proj_b[i], w_out[i], g_ffn[i],
               w_up[i], ffn_conv_w[i], ffn_conv_b[i], w_down[i], g_ple[i], w_ple_gate[i], w_ple[i])
        yp, st_p = layer(yp, p_prompt[i], None,
                         jnp.zeros((bp, SSM_CONV - 1, CONV_DIM), yp.dtype),
                         jnp.zeros((bp, N_HEADS_S, SSM_HEAD_DIM, D_STATE), jnp.float32),
                         jnp.zeros((bp, FFN_CONV - 1, 2 * D_FF), yp.dtype), prm)
        ys, st_s = layer(ys, p_sample[i], (cache_k[i], cache_v[i]), state_conv_ssm[i], state_ssm[i],
                         state_conv_ffn[i], prm)
        sp.append(st_p)
        ss.append(st_s)

    def stack(lst, j):
        return jnp.stack([s[j] for s in lst], axis=0)

    return (yp, ys,
            stack(sp, 0), stack(sp, 1), stack(sp, 2), stack(sp, 3), stack(sp, 4),
            stack(ss, 0), stack(ss, 1), stack(ss, 2), stack(ss, 3), stack(ss, 4))
```

```cpp
#include <hip/hip_runtime.h>
#include <hip/hip_cooperative_groups.h>
#include <cstdio>
#include <cstdint>
namespace cg = cooperative_groups;
namespace pg8 {
#define PG8_LAS __attribute__((address_space(3)))
typedef unsigned short bf16_t;
typedef short bf16x8 __attribute__((ext_vector_type(8)));
typedef float f32x4 __attribute__((ext_vector_type(4)));
typedef unsigned u32x4 __attribute__((ext_vector_type(4)));
constexpr int BM = 256, BK = 64, HALF = 128, HTB = HALF * BK * 2  , STAGE_BYTES = 8 * HTB, NXCD = 8, WGM = 8;

__host__ __device__ __forceinline__ int lds_byte(int r, int c) { const int st = (r >> 4) * 2 + (c >> 5), rr = r & 15, cc = c & 31, ob = rr * 64 + cc * 2; return st * 1024 + (ob ^ (((ob >> 9) & 1) << 5)); }
__host__ __device__ __forceinline__ void stage_rc(int b, int& R, int& C) { const int st = b / 1024, sb = b % 1024, swz = sb ^ (((sb >> 9) & 1) << 5); R = (st >> 1) * 16 + swz / 64; C = (st & 1) * 32 + (swz % 64) / 2; }
__host__ __device__ __forceinline__ int perm32(int rho) { const int n = rho >> 4, i = rho & 15; return 8 * (i >> 2) + 4 * n + (i & 3); }

struct Unit { int pm, pn; };
struct Gemm { const bf16_t* A; const bf16_t* Bt; int M, N, K; };

struct StaticOrder {
    int nM, nN, nwg, G, c;
    __host__ __device__ __forceinline__ void init(int M, int N, int G_, int c_) { nM = M / BM; nN = N / BM; nwg = nM * nN; G = G_; c = c_; }
    __host__ __device__ __forceinline__ bool next(int i, Unit& u) const {
        const long L = (long)i * G + c; if (L >= nwg) return false;
        int wgid = (int)L; { const int q = nwg / NXCD, r = nwg % NXCD, xcd = wgid % NXCD, off = wgid / NXCD; wgid = (xcd < r ? xcd * (q + 1) : r * (q + 1) + (xcd - r) * q) + off; }
        const int nig = WGM * nN, gid = wgid / nig, fm = gid * WGM, gsz = (nM - fm) < WGM ? (nM - fm) : WGM;
        u.pm = fm + ((wgid % nig) % gsz); u.pn = (wgid % nig) / gsz; return true;
    }
    __device__ __forceinline__ void a_ready(const Unit&) const {}
    __device__ __forceinline__ void done(const Unit&) const {}
};

__device__ __forceinline__ unsigned cvt_pk_bf16(float lo, float hi) { unsigned r; asm volatile("v_cvt_pk_bf16_f32 %0, %1, %2" : "=v"(r) : "v"(lo), "v"(hi)); return r; }
template <class Epi, class Sched, bool ALIGN_EPI = false, bool SP2 = false>
__device__ __forceinline__ void gemm_phase(PG8_LAS unsigned char* lds, const Gemm g, const Sched& S, const Epi& E, int tid_in) {
    int tid_l = tid_in; asm volatile("" : "+v"(tid_l)); const int tid = tid_l, wid = __builtin_amdgcn_readfirstlane(tid >> 6), lane = tid & 63, wr = wid >> 2, wc = wid & 3, fr = lane & 15, fq = lane >> 4;
    const int K = g.K, nt = K / BK;
    unsigned voffA[2], voffB[2];
#pragma unroll
    for (int i = 0; i < 2; ++i) { int R, C; stage_rc(tid * 16 + i * 8192, R, C); const int Rb = Epi::PERM ? ((R & ~31) + perm32(R & 31)) : R;
        voffA[i] = (unsigned)(R * K + C) * 2u; voffB[i] = (unsigned)(Rb * K + C) * 2u; }
    const size_t kstep = (size_t)(BK * 2);
    const size_t hstep = (size_t)HALF * K * 2;
    const size_t tstep = 2 * hstep;
    const unsigned ldsw = (unsigned)wid * 1024u;
    const int aoff = lds_byte(wr * 64 + fr, fq * 8), boff = lds_byte(wc * 32 + fr, fq * 8);
#define PG8_SA(b, h) (((b) * 2 + (h)) * HTB)
#define PG8_SB(b, h) ((4 + (b) * 2 + (h)) * HTB)
#define PG8_STAGE(bufoff, gbase, voff) do { _Pragma("unroll") for (int _i = 0; _i < 2; ++_i) \
        __builtin_amdgcn_global_load_lds((const unsigned*)((const char*)(gbase) + (voff)[_i]), (PG8_LAS unsigned*)(lds + (bufoff) + ldsw + _i * 8192), 16, 0, 0); } while (0)
#define PG8_LDA(dst, b, h) do { _Pragma("unroll") for (int m = 0; m < 4; ++m) _Pragma("unroll") for (int k = 0; k < 2; ++k) dst[m][k] = *(const PG8_LAS bf16x8*)(lds + PG8_SA(b, h) + aoff + m * 2048 + k * 1024); } while (0)
#define PG8_LDB(dst, b, h) do { _Pragma("unroll") for (int n = 0; n < 2; ++n) _Pragma("unroll") for (int k = 0; k < 2; ++k) dst[n][k] = *(const PG8_LAS bf16x8*)(lds + PG8_SB(b, h) + boff + n * 2048 + k * 1024); } while (0)
#define PG8_MMA(ai, bj, At, Bt) do { __builtin_amdgcn_s_setprio(1); _Pragma("unroll") for (int m = 0; m < 4; ++m) _Pragma("unroll") for (int n = 0; n < 2; ++n) _Pragma("unroll") for (int k = 0; k < 2; ++k) \
        acc[ai][bj][m][n] = __builtin_amdgcn_mfma_f32_16x16x32_bf16(Bt[n][k], At[m][k], acc[ai][bj][m][n], 0, 0, 0); __builtin_amdgcn_s_setprio(0); } while (0)
#define PG8_WAIT_V(n) asm volatile("s_waitcnt vmcnt(" #n ")" ::: "memory")
#define PG8_WAIT_L(n) asm volatile("s_waitcnt lgkmcnt(" #n ")" ::: "memory")
#define PG8_BAR __builtin_amdgcn_s_barrier()
#define PG8_SCHED __builtin_amdgcn_sched_barrier(0)
    Unit cur, nxt; int ui = 0;
    if (!S.next(0, cur)) return;
    f32x4 acc[2][2][4][2];
#pragma unroll
    for (int a = 0; a < 2; ++a)
#pragma unroll
        for (int b = 0; b < 2; ++b)
#pragma unroll
            for (int m = 0; m < 4; ++m)
#pragma unroll
                for (int n = 0; n < 2; ++n) acc[a][b][m][n] = (f32x4){0.f, 0.f, 0.f, 0.f};
    bf16x8 At[4][2], B0[2][2], B1[2][2];
    const char* cA = (const char*)g.A + (size_t)cur.pm * tstep; const char* cB = (const char*)g.Bt + (size_t)cur.pn * tstep;
    S.a_ready(cur);
    if constexpr (SP2) {
        PG8_STAGE(PG8_SB(0, 0), cB, voffB); PG8_STAGE(PG8_SB(0, 1), cB + hstep, voffB); PG8_STAGE(PG8_SA(0, 0), cA, voffA); PG8_STAGE(PG8_SA(0, 1), cA + hstep, voffA);
        if (wr == 1) PG8_BAR;
        PG8_WAIT_V(2); PG8_BAR;
        PG8_STAGE(PG8_SB(1, 0), cB + kstep, voffB); PG8_STAGE(PG8_SA(1, 0), cA + kstep, voffA); PG8_STAGE(PG8_SB(1, 1), cB + hstep + kstep, voffB);
        PG8_WAIT_V(6); PG8_BAR;
    } else {
        PG8_STAGE(PG8_SB(0, 0), cB, voffB); PG8_STAGE(PG8_SA(0, 0), cA, voffA); PG8_STAGE(PG8_SB(0, 1), cB + hstep, voffB); PG8_STAGE(PG8_SA(0, 1), cA + hstep, voffA);
        if (wr == 1) PG8_BAR;
        PG8_WAIT_V(4); PG8_BAR;
        PG8_STAGE(PG8_SB(1, 0), cB + kstep, voffB); PG8_STAGE(PG8_SA(1, 0), cA + kstep, voffA); PG8_STAGE(PG8_SB(1, 1), cB + hstep + kstep, voffB);
        PG8_WAIT_V(6); PG8_BAR;
    }
    for (;;) {
        const bool has_next = S.next(ui + 1, nxt);
        const char* nA = has_next ? (const char*)g.A + (size_t)nxt.pm * tstep : cA; const char* nB = has_next ? (const char*)g.Bt + (size_t)nxt.pn * tstep : cB;
        for (int t = 0; t < nt; t += 2) {
            const bool last = (t == nt - 2);
            const char* a1 = cA + (size_t)(t + 1) * kstep;
            const char* a2 = last ? nA : cA + (size_t)(t + 2) * kstep; const char* b2 = last ? nB : cB + (size_t)(t + 2) * kstep;
            const char* a3 = a2 + kstep; const char* b3 = b2 + kstep;
            if (last && has_next) S.a_ready(nxt);
            if constexpr (SP2) {
            PG8_LDB(B0, 0, 0); PG8_LDB(B1, 0, 1); PG8_SCHED; PG8_LDA(At, 0, 0); PG8_STAGE(PG8_SA(1, 1), a1 + hstep, voffA);
            PG8_WAIT_V(8); PG8_WAIT_L(0); PG8_BAR; PG8_MMA(0, 0, At, B0); PG8_MMA(0, 1, At, B1); PG8_BAR; PG8_SCHED;
            PG8_LDA(At, 0, 1); PG8_STAGE(PG8_SB(0, 0), b2, voffB); PG8_STAGE(PG8_SB(0, 1), b2 + hstep, voffB); PG8_STAGE(PG8_SA(0, 0), a2, voffA);
            PG8_WAIT_V(8); PG8_WAIT_L(0); PG8_BAR; PG8_MMA(1, 0, At, B0); PG8_MMA(1, 1, At, B1); PG8_BAR; PG8_SCHED;
            PG8_LDB(B0, 1, 0); PG8_LDB(B1, 1, 1); PG8_SCHED; PG8_LDA(At, 1, 0); PG8_STAGE(PG8_SA(0, 1), a2 + hstep, voffA);
            PG8_WAIT_V(8); PG8_WAIT_L(0); PG8_BAR; PG8_MMA(0, 0, At, B0); PG8_MMA(0, 1, At, B1); PG8_BAR; PG8_SCHED;
            PG8_LDA(At, 1, 1); PG8_STAGE(PG8_SB(1, 0), b3, voffB); PG8_STAGE(PG8_SB(1, 1), b3 + hstep, voffB); PG8_STAGE(PG8_SA(1, 0), a3, voffA);
            PG8_WAIT_V(8); PG8_WAIT_L(0); PG8_BAR; PG8_MMA(1, 0, At, B0); PG8_MMA(1, 1, At, B1); PG8_BAR; PG8_SCHED;
            } else {
            PG8_LDB(B0, 0, 0); PG8_SCHED; PG8_LDA(At, 0, 0); PG8_STAGE(PG8_SA(1, 1), a1 + hstep, voffA);
            PG8_WAIT_L(8); PG8_BAR; PG8_WAIT_L(0); PG8_MMA(0, 0, At, B0); PG8_BAR; PG8_SCHED;
            PG8_LDB(B1, 0, 1); PG8_STAGE(PG8_SB(0, 0), b2, voffB);
            PG8_BAR; PG8_WAIT_L(0); PG8_MMA(0, 1, At, B1); PG8_BAR;
            PG8_LDA(At, 0, 1); PG8_STAGE(PG8_SA(0, 0), a2, voffA);
            PG8_BAR; PG8_WAIT_L(0); PG8_MMA(1, 0, At, B0); PG8_BAR; PG8_SCHED;
            PG8_STAGE(PG8_SB(0, 1), b2 + hstep, voffB);
            PG8_WAIT_V(6); PG8_BAR; PG8_MMA(1, 1, At, B1); PG8_BAR;
            PG8_LDB(B0, 1, 0); PG8_SCHED; PG8_LDA(At, 1, 0); PG8_STAGE(PG8_SA(0, 1), a2 + hstep, voffA);
            PG8_WAIT_L(8); PG8_BAR; PG8_WAIT_L(0); PG8_MMA(0, 0, At, B0); PG8_BAR; PG8_SCHED;
            PG8_LDB(B1, 1, 1); PG8_STAGE(PG8_SB(1, 0), b3, voffB);
            PG8_BAR; PG8_WAIT_L(0); PG8_MMA(0, 1, At, B1); PG8_BAR;
            PG8_LDA(At, 1, 1); PG8_STAGE(PG8_SA(1, 0), a3, voffA);
            PG8_BAR; PG8_WAIT_L(0); PG8_MMA(1, 0, At, B0); PG8_BAR; PG8_SCHED;
            PG8_STAGE(PG8_SB(1, 1), b3 + hstep, voffB);
            PG8_WAIT_V(6); PG8_BAR; PG8_MMA(1, 1, At, B1); PG8_BAR;
            }
        }
        if constexpr (ALIGN_EPI) { if (wr == 0) PG8_BAR; }
        if constexpr (!Epi::AFTER_DRAIN) { E(acc, cur, wr, wc, fr, fq); S.done(cur); }
        if (!has_next) break;
#pragma unroll
        for (int a = 0; a < 2; ++a)
#pragma unroll
            for (int b = 0; b < 2; ++b)
#pragma unroll
                for (int m = 0; m < 4; ++m)
#pragma unroll
                    for (int n = 0; n < 2; ++n) acc[a][b][m][n] = (f32x4){0.f, 0.f, 0.f, 0.f};
        cur = nxt; cA = nA; cB = nB; ++ui;
        if constexpr (ALIGN_EPI) { if (wr == 1) PG8_BAR; }
    }
    PG8_WAIT_V(0);
    if constexpr (!ALIGN_EPI) { if (wr == 0) PG8_BAR; }
    PG8_BAR;
    if constexpr (Epi::AFTER_DRAIN) { E.fused(acc, cur, wr, wc, fr, fq, lds, wid, lane); S.done(cur); }
#undef PG8_SA
#undef PG8_SB
#undef PG8_STAGE
#undef PG8_LDA
#undef PG8_LDB
#undef PG8_MMA
#undef PG8_WAIT_V
#undef PG8_WAIT_L
#undef PG8_BAR
#undef PG8_SCHED
}
}

#define LAS __attribute__((address_space(3)))
typedef unsigned short bf16_t;
typedef short bf16x8 __attribute__((ext_vector_type(8)));
typedef short s16x4 __attribute__((ext_vector_type(4)));
typedef float f32x4 __attribute__((ext_vector_type(4)));
typedef unsigned u32x4 __attribute__((ext_vector_type(4)));
typedef unsigned u32x2 __attribute__((ext_vector_type(2)));

constexpr int DM = 1024, SEQ = 2048, NHA = 16, NHS = 32, CONVD = 3072, DFF = 3072, PLE = 256;
constexpr int NIN = 10272, NINP = 41 * 256;
constexpr int GROWS = 16384, TMAX = 16640;
constexpr float EPS = 1e-6f, LOG2E = 1.4426950408889634f, QSCALE = 0.125f * 1.4426950408889634f;

constexpr size_t O_YP = 0, O_YS = 33554432, O_KP = O_YS + 262144, O_VP = O_KP + 8388608, O_SSMP = O_VP + 8388608, O_CSP = O_SSMP + 4194304,
                 O_CFP = O_CSP + 147456, O_KS = O_CFP + 196608, O_VS = O_KS + 262144, O_SSMS = O_VS + 262144, O_CSS = O_SSMS + 2097152, O_CFS = O_CSS + 73728;

constexpr size_t al256(size_t x) { return (x + 255) & ~(size_t)255; }
constexpr size_t WS_W1T = 65536;
constexpr size_t WS_WAT = WS_W1T + (size_t)NINP * 1024 * 2;
constexpr size_t WS_WBT = WS_WAT + (size_t)1024 * 1024 * 2;
constexpr size_t WS_WOT = WS_WBT + (size_t)1024 * 2048 * 2;
constexpr size_t WS_WUT = WS_WOT + (size_t)1024 * 1024 * 2;
constexpr size_t WS_WDT = WS_WUT + (size_t)6144 * 1024 * 2;
constexpr size_t WS_WGT = WS_WDT + (size_t)1024 * 3072 * 2;
constexpr size_t WS_WPT = WS_WGT + (size_t)1024 * 1024 * 2;
constexpr size_t WS_KS  = WS_WPT + (size_t)1024 * 256 * 2;
constexpr size_t WS_VTS = WS_KS + (size_t)8 * 576 * 1024 * 2;
constexpr size_t WS_SSQ = WS_VTS + (size_t)8 * 576 * 1024 * 2;
constexpr size_t WS_SSX = WS_SSQ + al256((size_t)TMAX * 32 * 4);
constexpr size_t WS_H   = WS_SSX + al256((size_t)TMAX * 16 * 4);
constexpr size_t WS_Q   = WS_H + (size_t)TMAX * 1024 * 2;
constexpr size_t WS_K   = WS_Q + (size_t)TMAX * 1024 * 2;
constexpr size_t WS_VT  = WS_K + (size_t)TMAX * 1024 * 2;
constexpr size_t WS_Z   = WS_VT + (size_t)8 * 1024 * 2048 * 2;
constexpr size_t WS_XBC = WS_Z + (size_t)TMAX * 2048 * 2;
constexpr size_t WS_GT  = WS_XBC + (size_t)TMAX * 3072 * 2;
constexpr size_t WS_DT  = WS_GT + (size_t)TMAX * 2048 * 2;
constexpr size_t WS_PE  = WS_DT + (size_t)TMAX * 32 * 4;
constexpr size_t WS_PE1 = WS_PE + (size_t)TMAX * 256 * 2;
constexpr size_t WS_H1  = WS_PE1 + (size_t)TMAX * 256 * 2;
constexpr size_t WS_END = WS_H1 + (size_t)TMAX * 1024 * 2;
constexpr size_t WS_U   = WS_K;
constexpr size_t WS_GA  = WS_U + (size_t)TMAX * 6144 * 2;
constexpr size_t WS_ST  = WS_H;
constexpr size_t WS_XB  = WS_Q;
static_assert(WS_GA + (size_t)TMAX * 3072 * 2 <= WS_PE, "ffn overlay");
static_assert(WS_END <= (size_t)512 * 1024 * 1024, "ws budget");

constexpr int LDS_BYTES = 157696;

struct Params { const float* in[32]; float* out; unsigned char* ws; int ph_lo, ph_hi; };

enum { I_XP = 0, I_XS, I_CK, I_CV, I_SSM, I_CSSM, I_CFFN, I_PP, I_PS, I_GMIX, I_WIN, I_BGATE, I_GQ, I_GK, I_REL, I_CSW, I_CSB, I_DTB, I_ALOG, I_DSKIP, I_GSSM,
       I_WPA, I_WPB, I_WOUT, I_GFFN, I_WUP, I_FCW, I_FCB, I_WDOWN, I_GPLE, I_WPG, I_WPLE };

__device__ __forceinline__ int ltid_w(int wv) { int t = wv * 64 + (int)__builtin_amdgcn_mbcnt_hi(~0u, __builtin_amdgcn_mbcnt_lo(~0u, 0u)); asm volatile("" : "+v"(t)); return t; }
__device__ __forceinline__ int lbid() { int t = blockIdx.x; asm volatile("" : "+s"(t)); return t; }
__device__ __forceinline__ unsigned char* lws(const struct Params& P);
typedef float f32x2_t __attribute__((ext_vector_type(2))); typedef __bf16 bf16x2_t __attribute__((ext_vector_type(2)));
__device__ __forceinline__ unsigned pk2(float lo, float hi) { f32x2_t v = {lo, hi}; bf16x2_t r = __builtin_convertvector(v, bf16x2_t); return __builtin_bit_cast(unsigned, r); }
__device__ __forceinline__ float bf2f(unsigned short b) { return __uint_as_float(((unsigned)b) << 16); }
__device__ __forceinline__ float bflo(unsigned w) { return __uint_as_float(w << 16); }
__device__ __forceinline__ float bfhi(unsigned w) { return __uint_as_float(w & 0xffff0000u); }
__device__ __forceinline__ float sigmoidf_(float x) { return __builtin_amdgcn_rcpf(1.f + __builtin_amdgcn_exp2f(-LOG2E * x)); }
__device__ __forceinline__ float siluf_(float x) { return x * __builtin_amdgcn_rcpf(1.f + __builtin_amdgcn_exp2f(-LOG2E * x)); }
__device__ __forceinline__ float wave_sum(float v) {
#pragma unroll
    for (int o = 1; o < 64; o <<= 1) v += __shfl_xor(v, o);
    return v;
}
__device__ __forceinline__ u32x4 pack8(const float* v) { u32x4 w; w.x = pk2(v[0], v[1]); w.y = pk2(v[2], v[3]); w.z = pk2(v[4], v[5]); w.w = pk2(v[6], v[7]); return w; }
__device__ __forceinline__ void unpack8(u32x4 w, float* v) { v[0] = bflo(w.x); v[1] = bfhi(w.x); v[2] = bflo(w.y); v[3] = bfhi(w.y); v[4] = bflo(w.z); v[5] = bfhi(w.z); v[6] = bflo(w.w); v[7] = bfhi(w.w); }

__device__ __forceinline__ unsigned char* lws(const Params& P) { int z = 0; asm volatile("" : "+s"(z)); return P.ws + z; }
__device__ __forceinline__ const float* xrow(const Params& P, int g, int lr) { return lr < GROWS ? P.in[I_XP] + ((size_t)g * GROWS + lr) * DM : P.in[I_XS] + (size_t)(lr - GROWS) * DM; }
__device__ __forceinline__ float* yrow(const Params& P, int g, int lr) { return lr < GROWS ? P.out + O_YP + ((size_t)g * GROWS + lr) * DM : P.out + O_YS + (size_t)(lr - GROWS) * DM; }
__device__ __forceinline__ int grows(int g) { return g == 0 ? GROWS : TMAX; }

enum { M_IN = 0, M_PA, M_PB, M_OUT, M_UP, M_DOWN, M_PG, M_PLE };
struct Epi {
    static constexpr bool PERM = true, AFTER_DRAIN = false;
    const float *xp, *xs, *gq, *gk, *bgate, *dtb; float* out; unsigned char* wsb; int mode; int g; const LAS float* ev; int rsb;
    __device__ __forceinline__ void operator()(const f32x4 (&acc)[2][2][4][2], const pg8::Unit& u, int wr, int wc, int fr_, int fq_) const {
        int fr = fr_, fq = fq_; asm volatile("" : "+v"(fr), "+v"(fq));
        const int lane_ = fr + 16 * fq;
        unsigned char* ws = wsb;
        const int r0 = wr * 64 + fr;
        const int cb = wc * 32 + fq * 8;
        const bool smp = (u.pm == 64);
        if (mode == M_IN) {
            const int pn = u.pn;
            if (pn < 8) {
                const bool isk = pn >= 4; const int head = 4 * (pn & 3) + wc;
                const LAS float* gw = ev + (isk ? 64 : 0);
                float gv[2][8];
#pragma unroll
                for (int bj = 0; bj < 2; ++bj)
#pragma unroll
                    for (int e = 0; e < 8; ++e) gv[bj][e] = gw[32 * bj + 8 * fq + e];
#pragma unroll
                for (int ai = 0; ai < 2; ++ai)
#pragma unroll
                    for (int m = 0; m < 4; ++m) {
                        const int r = ai * 128 + m * 16 + r0; const int lr = u.pm * 256 + r;
                        float ss = 0.f;
#pragma unroll
                        for (int bj = 0; bj < 2; ++bj)
#pragma unroll
                            for (int n = 0; n < 2; ++n) { const f32x4 x = acc[ai][bj][m][n]; ss += x[0] * x[0] + x[1] * x[1] + x[2] * x[2] + x[3] * x[3]; }
                        ss += __shfl_xor(ss, 16); ss += __shfl_xor(ss, 32);
                        const float rs = rsqrtf(ss * (1.f / 64.f) + EPS);
                        int b, t; if (smp) { b = r >> 5; t = r & 31; } else { b = g * 8 + (u.pm >> 3); t = (u.pm & 7) * 256 + r; }
#pragma unroll
                        for (int bj = 0; bj < 2; ++bj) {
                            float v[8];
#pragma unroll
                            for (int e = 0; e < 8; ++e) v[e] = acc[ai][bj][m][e >> 2][e & 3] * rs * gv[bj][e];
                            const int col = head * 64 + 32 * bj + 8 * fq;
                            if (!isk) {
#pragma unroll
                                for (int e = 0; e < 8; ++e) v[e] *= QSCALE;
                                *(u32x4*)((bf16_t*)(ws + WS_Q) + (size_t)lr * 1024 + col) = pack8(v);
                            } else {
                                const int tk = smp ? 512 + t : t;
                                bf16_t* dst = (smp ? (bf16_t*)(ws + WS_KS) + ((size_t)b * 16 + head) * 576 * 64 : (bf16_t*)(ws + WS_K) + ((size_t)(u.pm >> 3) * 16 + head) * 2048 * 64)
                                              + (size_t)(tk >> 4) * 1024 + bj * 512 + fq * 128 + (tk & 15) * 8;
                                *(u32x4*)dst = pack8(v);
                                float* o = nullptr;
                                if (smp) o = out + O_KS + ((size_t)b * 32 + t) * 1024 + col; else if (t >= 1536) o = out + O_KP + ((size_t)b * 512 + (t - 1536)) * 1024 + col;
                                if (o) { *(f32x4*)o = (f32x4){v[0], v[1], v[2], v[3]}; *(f32x4*)(o + 4) = (f32x4){v[4], v[5], v[6], v[7]}; }
                            }
                        }
                    }
            } else if (pn < 12) {
#pragma unroll
                for (int ai = 0; ai < 2; ++ai)
#pragma unroll
                    for (int m = 0; m < 4; ++m) {
                        const int r = ai * 128 + m * 16 + r0;
                        int b, t; if (smp) { b = r >> 5; t = r & 31; } else { b = g * 8 + (u.pm >> 3); t = (u.pm & 7) * 256 + r; }
#pragma unroll
                        for (int bj = 0; bj < 2; ++bj) {
                            const int ch = (pn - 8) * 256 + bj * 128 + cb;
                            const int tt_ = smp ? 512 + t : t, j = fr & 3;
                            float v[8];
#pragma unroll
                            for (int e = 0; e < 8; ++e) v[e] = acc[ai][bj][m][e >> 2][e & 3];
                            const unsigned p0 = pk2(v[0], v[1]), p1 = pk2(v[2], v[3]), p2 = pk2(v[4], v[5]), p3 = pk2(v[6], v[7]);
                            unsigned got[4];
#pragma unroll
                            for (int r = 0; r < 4; ++r) { const int si = (j - r) & 3; const unsigned send = si == 0 ? p0 : (si == 1 ? p1 : (si == 2 ? p2 : p3)); got[r] = (unsigned)__shfl((int)send, (lane_ & ~3) | ((j + r) & 3)); }
                            unsigned tk[4];
#pragma unroll
                            for (int k = 0; k < 4; ++k) { const int gi = (k - j) & 3; tk[k] = gi == 0 ? got[0] : (gi == 1 ? got[1] : (gi == 2 ? got[2] : got[3])); }
                            u32x4 w; w.x = (tk[0] & 0xffffu) | (tk[1] << 16); w.y = (tk[2] & 0xffffu) | (tk[3] << 16); w.z = (tk[0] >> 16) | (tk[1] & 0xffff0000u); w.w = (tk[2] >> 16) | (tk[3] & 0xffff0000u);
                            *(u32x4*)((smp ? (bf16_t*)(ws + WS_VTS) + (size_t)b * 576 * 1024 : (bf16_t*)(ws + WS_VT) + (size_t)(u.pm >> 3) * 2048 * 1024) + ((size_t)((tt_ - j) >> 2) * 1024 + ch + 2 * j) * 4) = w;
                            float* o = nullptr;
                            if (smp) o = out + O_VS + ((size_t)b * 32 + t) * 1024 + ch; else if (t >= 1536) o = out + O_VP + ((size_t)b * 512 + (t - 1536)) * 1024 + ch;
                            if (o) { *(f32x4*)o = (f32x4){v[0], v[1], v[2], v[3]}; *(f32x4*)(o + 4) = (f32x4){v[4], v[5], v[6], v[7]}; }
                        }
                    }
            } else if (pn < 40) {
                const int kind = pn < 20 ? 0 : (pn < 32 ? 1 : 2);
                const int ct0 = (kind == 0 ? (pn - 12) : kind == 1 ? (pn - 20) : (pn - 32)) * 256;
                const int ld = kind == 1 ? 3072 : 2048;
                bf16_t* base = (bf16_t*)(ws + (kind == 0 ? WS_Z : kind == 1 ? WS_XBC : WS_GT));
                float bv[2][8];
#pragma unroll
                for (int bj = 0; bj < 2; ++bj)
#pragma unroll
                    for (int e = 0; e < 8; ++e) bv[bj][e] = kind == 2 ? ev[256 + ct0 + bj * 128 + cb + e] : 0.f;
#pragma unroll
                for (int ai = 0; ai < 2; ++ai)
#pragma unroll
                    for (int m = 0; m < 4; ++m) {
                        const int r = ai * 128 + m * 16 + r0; const int lr = u.pm * 256 + r;
                        int b, t, len; if (smp) { b = r >> 5; t = r & 31; len = 32; } else { b = g * 8 + (u.pm >> 3); t = (u.pm & 7) * 256 + r; len = 2048; }
#pragma unroll
                        for (int bj = 0; bj < 2; ++bj) {
                            const int col = ct0 + bj * 128 + cb;
                            float v[8];
#pragma unroll
                            for (int e = 0; e < 8; ++e) { float x = acc[ai][bj][m][e >> 2][e & 3]; v[e] = kind == 2 ? sigmoidf_(x + bv[bj][e]) : x; }
                            *(u32x4*)(base + (size_t)lr * ld + col) = pack8(v);
                            if (kind == 1 && t >= len - 3) {
                                float* o = smp ? out + O_CSS + ((size_t)b * 3 + (t - 29)) * 3072 + col : out + O_CSP + ((size_t)b * 3 + (t - 2045)) * 3072 + col;
                                *(f32x4*)o = (f32x4){v[0], v[1], v[2], v[3]}; *(f32x4*)(o + 4) = (f32x4){v[4], v[5], v[6], v[7]};
                            }
                        }
                    }
            } else {
                if (wc == 0) {
                    float db[8];
#pragma unroll
                    for (int e = 0; e < 8; ++e) db[e] = ev[128 + 8 * fq + e];
#pragma unroll
                    for (int ai = 0; ai < 2; ++ai)
#pragma unroll
                        for (int m = 0; m < 4; ++m) {
                            const int lr = u.pm * 256 + ai * 128 + m * 16 + r0;
                            float v[8];
#pragma unroll
                            for (int e = 0; e < 8; ++e) { const float x = acc[ai][0][m][e >> 2][e & 3] + db[e]; v[e] = x > 20.f ? x : log1pf(__expf(x)); }
                            float* o = (float*)(ws + WS_DT) + (size_t)lr * 32 + 8 * fq;
                            *(f32x4*)o = (f32x4){v[0], v[1], v[2], v[3]}; *(f32x4*)(o + 4) = (f32x4){v[4], v[5], v[6], v[7]};
                        }
                }
            }
            return;
        }
#pragma unroll
        for (int ai = 0; ai < 2; ++ai)
#pragma unroll
            for (int m = 0; m < 4; ++m) {
                const int r = ai * 128 + m * 16 + r0; const int lr = u.pm * 256 + r;
                float rs = 1.f, rss = 0.f;
                const bool rs_lds = (mode == M_PB || mode == M_UP || mode == M_PG) && ((u.pm >> 3) << 3) == rsb;
                if (rs_lds) rs = ev[(u.pm & 7) * 256 + r];
                if (!rs_lds && (mode == M_UP || mode == M_PG)) { const f32x4* sp = (const f32x4*)((const float*)(ws + WS_SSX) + (size_t)lr * 16); float s = 0.f;
#pragma unroll
                    for (int q4 = 0; q4 < 4; ++q4) { const f32x4 x = sp[q4]; s += (x[0] + x[1]) + (x[2] + x[3]); }
                    rs = rsqrtf(s * (1.f / 1024.f) + EPS); }
                if (!rs_lds && mode == M_PB) { const f32x4* sp = (const f32x4*)((const float*)(ws + WS_SSQ) + (size_t)lr * 32); float s = 0.f;
#pragma unroll
                    for (int q4 = 0; q4 < 8; ++q4) { const f32x4 x = sp[q4]; s += (x[0] + x[1]) + (x[2] + x[3]); }
                    rs = rsqrtf(s * (1.f / 2048.f) + EPS); }
#pragma unroll
                for (int bj = 0; bj < 2; ++bj) {
                    const int col = u.pn * 256 + bj * 128 + cb;
                    float a[8];
#pragma unroll
                    for (int e = 0; e < 8; ++e) a[e] = acc[ai][bj][m][e >> 2][e & 3];
                    if (mode == M_PA || mode == M_PB) {
                        bf16_t* mp = (bf16_t*)(ws + WS_H) + (size_t)lr * 1024 + col;
                        float gt[8]; unpack8(*(const u32x4*)((const bf16_t*)(ws + WS_GT) + (size_t)lr * 2048 + (mode == M_PB ? 1024 : 0) + col), gt);
                        float v[8];
                        if (mode == M_PA) {
#pragma unroll
                            for (int e = 0; e < 8; ++e) v[e] = gt[e] * a[e];
                        } else {
                            float s[8]; unpack8(*(const u32x4*)mp, s);
#pragma unroll
                            for (int e = 0; e < 8; ++e) v[e] = s[e] + gt[e] * rs * a[e];
                        }
                        *(u32x4*)mp = pack8(v);
                    } else if (mode == M_OUT || mode == M_DOWN) {
                        bf16_t* xbp = (bf16_t*)(ws + WS_XB) + (size_t)lr * 1024 + col;
                        float v[8];
                        if (mode == M_OUT) {
                            const float* xr = (lr < GROWS ? xp + ((size_t)g * GROWS + lr) * DM : xs + (size_t)(lr - GROWS) * DM) + col;
                            const f32x4 x0 = *(const f32x4*)xr, x1 = *(const f32x4*)(xr + 4);
                            v[0] = x0[0]; v[1] = x0[1]; v[2] = x0[2]; v[3] = x0[3]; v[4] = x1[0]; v[5] = x1[1]; v[6] = x1[2]; v[7] = x1[3];
                        } else unpack8(*(const u32x4*)xbp, v);
#pragma unroll
                        for (int e = 0; e < 8; ++e) v[e] += a[e];
                        *(u32x4*)xbp = pack8(v);
#pragma unroll
                        for (int e = 0; e < 8; ++e) rss += v[e] * v[e];
                    } else if (mode == M_UP) {
#pragma unroll
                        for (int e = 0; e < 8; ++e) a[e] *= rs;
                        *(u32x4*)((bf16_t*)(ws + WS_U) + (size_t)lr * 6144 + col) = pack8(a);
                        int b, t, len; if (smp) { b = r >> 5; t = r & 31; len = 32; } else { b = g * 8 + (u.pm >> 3); t = (u.pm & 7) * 256 + r; len = 2048; }
                        if (t >= len - 2) {
                            float* o = smp ? out + O_CFS + ((size_t)b * 2 + (t - 30)) * 6144 + col : out + O_CFP + ((size_t)b * 2 + (t - 2046)) * 6144 + col;
                            *(f32x4*)o = (f32x4){a[0], a[1], a[2], a[3]}; *(f32x4*)(o + 4) = (f32x4){a[4], a[5], a[6], a[7]};
                        }
                    } else if (mode == M_PG) {
                        float v[8];
#pragma unroll
                        for (int e = 0; e < 8; ++e) v[e] = sigmoidf_(a[e] * rs);
                        *(u32x4*)((bf16_t*)(ws + WS_ST) + (size_t)lr * 1024 + col) = pack8(v);
                    } else {
                        float s[8]; unpack8(*(const u32x4*)((const bf16_t*)(ws + WS_ST) + (size_t)lr * 1024 + col), s);
                        float xv[8]; unpack8(*(const u32x4*)((const bf16_t*)(ws + WS_XB) + (size_t)lr * 1024 + col), xv);
                        float* yr = (lr < GROWS ? out + O_YP + ((size_t)g * GROWS + lr) * DM : out + O_YS + (size_t)(lr - GROWS) * DM) + col;
                        *(f32x4*)yr = (f32x4){xv[0] + s[0] * a[0], xv[1] + s[1] * a[1], xv[2] + s[2] * a[2], xv[3] + s[3] * a[3]};
                        *(f32x4*)(yr + 4) = (f32x4){xv[4] + s[4] * a[4], xv[5] + s[5] * a[5], xv[6] + s[6] * a[6], xv[7] + s[7] * a[7]};
                    }
                }
                if (mode == M_OUT || mode == M_DOWN) {
                    rss += __shfl_xor(rss, 16); rss += __shfl_xor(rss, 32);
                    if (fq == 0) ((float*)(ws + WS_SSX))[(size_t)lr * 16 + u.pn * 4 + wc] = rss;
                }
            }
    }
};

__device__ __forceinline__ void run_gemm(LAS unsigned char* lds, const Params& P, int mode, int g, const bf16_t* A, const bf16_t* Bt, int M, int N, int K, int wv) {
    pg8::Gemm gm{A, Bt, M, N, K}; pg8::StaticOrder S; S.init(M, N, (int)gridDim.x, lbid());
    if (mode == M_IN) {
        LAS float* ev = (LAS float*)(lds + 131072); const int t_ = ltid_w(wv);
        for (int i = t_; i < 2304; i += 512) ev[i] = i < 64 ? P.in[I_GQ][i] : (i < 128 ? P.in[I_GK][i - 64] : (i < 160 ? P.in[I_DTB][i - 128] : (i < 256 ? 0.f : P.in[I_BGATE][i - 256])));
        __syncthreads();
    }
    int rsb_ = -1;
    if (mode == M_PB || mode == M_UP || mode == M_PG) {
        pg8::Unit u0; const bool has_ = S.next(0, u0);
        if (has_) {
            rsb_ = (u0.pm >> 3) << 3;
            LAS float* rt = (LAS float*)(lds + 131072); const int t_ = ltid_w(wv); const unsigned char* ws_ = lws(P);
            for (int r = t_; r < 2048; r += 512) {
                const int lr = rsb_ * 256 + r; float s = 0.f;
                if (lr < M) {
                    if (mode == M_PB) { const f32x4* sp = (const f32x4*)((const float*)(ws_ + WS_SSQ) + (size_t)lr * 32);
#pragma unroll
                        for (int q4 = 0; q4 < 8; ++q4) { const f32x4 x = sp[q4]; s += (x[0] + x[1]) + (x[2] + x[3]); }
                        s = rsqrtf(s * (1.f / 2048.f) + EPS);
                    } else { const f32x4* sp = (const f32x4*)((const float*)(ws_ + WS_SSX) + (size_t)lr * 16);
#pragma unroll
                        for (int q4 = 0; q4 < 4; ++q4) { const f32x4 x = sp[q4]; s += (x[0] + x[1]) + (x[2] + x[3]); }
                        s = rsqrtf(s * (1.f / 1024.f) + EPS);
                    }
                }
                rt[r] = s;
            }
        }
        __syncthreads();
    }
    Epi E{P.in[I_XP], P.in[I_XS], P.in[I_GQ], P.in[I_GK], P.in[I_BGATE], P.in[I_DTB], P.out, lws(P), mode, g, (const LAS float*)(lds + 131072), rsb_};
    pg8::gemm_phase<Epi, pg8::StaticOrder, true, true>(lds, gm, S, E, ltid_w(wv));
    __syncthreads();
}

__device__ __forceinline__ void tr_item(const float* W, int ldsrc, int srccol0, int k0, bf16_t* WT, size_t dstrow0, int ldd, const float* kscale, LAS float* scr, int lane) {
#pragma unroll
    for (int i = 0; i < 8; ++i) { const int kk = 8 * i + (lane >> 3), c4 = (lane & 7) * 4; f32x4 v = (f32x4){0.f, 0.f, 0.f, 0.f};
        if (srccol0 >= 0) { v = *(const f32x4*)(W + (size_t)(k0 + kk) * ldsrc + srccol0 + c4); if (kscale) v = v * kscale[k0 + kk]; }
        scr[kk * 33 + c4] = v[0]; scr[kk * 33 + c4 + 1] = v[1]; scr[kk * 33 + c4 + 2] = v[2]; scr[kk * 33 + c4 + 3] = v[3]; }
    asm volatile("s_waitcnt lgkmcnt(0)" ::: "memory");
    const int c = lane & 7;
#pragma unroll
    for (int j = 0; j < 4; ++j) { const int n = (lane >> 3) + 8 * j; const LAS float* s = scr + (8 * c) * 33 + n;
        u32x4 o; o.x = pk2(s[0 * 33], s[1 * 33]); o.y = pk2(s[2 * 33], s[3 * 33]); o.z = pk2(s[4 * 33], s[5 * 33]); o.w = pk2(s[6 * 33], s[7 * 33]);
        *(u32x4*)(WT + (dstrow0 + n) * (size_t)ldd + k0 + 8 * c) = o; }
    asm volatile("s_waitcnt lgkmcnt(0)" ::: "memory");
}
__device__ __forceinline__ int win_srccol(int n0) {
    const int tile = n0 >> 8, tc = n0 & 255;
    if (tile < 8) { const int bj = tc >> 7, wc = (tc & 127) >> 5; return (tile < 4 ? 0 : 1024) + (4 * (tile & 3) + wc) * 64 + 32 * bj; }
    if (tile < 12) return 2048 + (tile - 8) * 256 + tc;
    if (tile < 20) return 3072 + (tile - 12) * 256 + tc;
    if (tile < 32) return 5120 + (tile - 20) * 256 + tc;
    if (tile < 40) return 8224 + (tile - 32) * 256 + tc;
    return tc < 32 ? 8192 + tc : -1;
}
__device__ __forceinline__ void tr_matrix(const float* W, int K, int ldsrc, int Ndst, bool winmap, bf16_t* WT, int ldd, const float* kscale, LAS float* scr, int gw, int NGW, int lane) {
    const int nblk = Ndst / 32, nit = (K / 64) * nblk;
    for (int it = gw; it < nit; it += NGW) { const int kb = it / nblk, nb = it % nblk; tr_item(W, ldsrc, winmap ? win_srccol(nb * 32) : nb * 32, kb * 64, WT, (size_t)nb * 32, ldd, kscale, scr, lane); }
}
__device__ __forceinline__ void prologue(const Params& P, LAS unsigned char* lds, int wv) {
    const int tid = ltid_w(wv), lane = tid & 63, wave = tid >> 6;
    LAS float* scr = (LAS float*)(lds + wave * 16384);
    const int gw = lbid() * 8 + wave, NGW = gridDim.x * 8;
    unsigned char* ws = lws(P);
    tr_matrix(P.in[I_WIN], 1024, NIN, NINP, true, (bf16_t*)(ws + WS_W1T), 1024, nullptr, scr, gw, NGW, lane);
    tr_matrix(P.in[I_WUP], 1024, 6144, 6144, false, (bf16_t*)(ws + WS_WUT), 1024, P.in[I_GFFN], scr, gw, NGW, lane);
    tr_matrix(P.in[I_WDOWN], 3072, 1024, 1024, false, (bf16_t*)(ws + WS_WDT), 3072, nullptr, scr, gw, NGW, lane);
    tr_matrix(P.in[I_WPB], 2048, 1024, 1024, false, (bf16_t*)(ws + WS_WBT), 2048, P.in[I_GSSM], scr, gw, NGW, lane);
    tr_matrix(P.in[I_WPA], 1024, 1024, 1024, false, (bf16_t*)(ws + WS_WAT), 1024, nullptr, scr, gw, NGW, lane);
    tr_matrix(P.in[I_WOUT], 1024, 1024, 1024, false, (bf16_t*)(ws + WS_WOT), 1024, nullptr, scr, gw, NGW, lane);
    tr_matrix(P.in[I_WPG], 1024, 1024, 1024, false, (bf16_t*)(ws + WS_WGT), 1024, P.in[I_GPLE], scr, gw, NGW, lane);
    tr_matrix(P.in[I_WPLE], 256, 1024, 1024, false, (bf16_t*)(ws + WS_WPT), 256, nullptr, scr, gw, NGW, lane);
    const size_t gt = (size_t)lbid() * 512 + tid, GT = (size_t)gridDim.x * 512;
    for (size_t i = gt; i < (size_t)8 * 512 * 128; i += GT) {
        const size_t b = i / (512 * 128), t = (i / 128) % 512, c8 = i % 128, head = c8 >> 3, d8 = c8 & 7;
        const f32x4 a = *(const f32x4*)(P.in[I_CK] + i * 8), c = *(const f32x4*)(P.in[I_CK] + i * 8 + 4);
        u32x4 w; w.x = pk2(a[0], a[1]); w.y = pk2(a[2], a[3]); w.z = pk2(c[0], c[1]); w.w = pk2(c[2], c[3]);
        *(u32x4*)((bf16_t*)(ws + WS_KS) + (b * 16 + head) * 576 * 64 + (t >> 4) * 1024 + (d8 >> 2) * 512 + (d8 & 3) * 128 + (t & 15) * 8) = w;
    }
    for (size_t i = gt; i < (size_t)8 * 16 * 256; i += GT) { const size_t bh = i / 256, rem = i % 256; *(u32x4*)((bf16_t*)(ws + WS_KS) + bh * 576 * 64 + (size_t)34 * 1024 + rem * 8) = (u32x4){0, 0, 0, 0}; }
    for (size_t i = gt; i < (size_t)8 * 128 * 128; i += GT) {
        const size_t b = i / (128 * 128), tg = (i / 128) % 128, c8 = i % 128;
        float v[4][8];
#pragma unroll
        for (int k = 0; k < 4; ++k) { const float* sp = P.in[I_CV] + ((b * 512 + tg * 4 + k) * 1024 + c8 * 8); const f32x4 a = *(const f32x4*)sp, c = *(const f32x4*)(sp + 4); v[k][0] = a[0]; v[k][1] = a[1]; v[k][2] = a[2]; v[k][3] = a[3]; v[k][4] = c[0]; v[k][5] = c[1]; v[k][6] = c[2]; v[k][7] = c[3]; }
        bf16_t* dp = (bf16_t*)(ws + WS_VTS) + b * 576 * 1024 + (tg * 1024 + c8 * 8) * 4;
#pragma unroll
        for (int e = 0; e < 8; e += 2) { u32x4 w; w.x = pk2(v[0][e], v[1][e]); w.y = pk2(v[2][e], v[3][e]); w.z = pk2(v[0][e + 1], v[1][e + 1]); w.w = pk2(v[2][e + 1], v[3][e + 1]); *(u32x4*)(dp + e * 4) = w; }
    }
    for (size_t i = gt; i < (size_t)8 * 8 * 512; i += GT) { const size_t b = i / (8 * 512), rem = i % (8 * 512); *(u32x4*)((bf16_t*)(ws + WS_VTS) + b * 576 * 1024 + (size_t)136 * 4096 + rem * 8) = (u32x4){0, 0, 0, 0}; }
}

__device__ __forceinline__ void norm_pass(const Params& P, int g, int wv) {
    const int tid = ltid_w(wv), lane = tid & 63, wave = tid >> 6;
    const int gw = lbid() * 8 + wave, NGW = gridDim.x * 8, nr = grows(g);
    const float* gvec = P.in[I_GMIX];
    f32x4 gv[4];
#pragma unroll
    for (int j = 0; j < 4; ++j) gv[j] = *(const f32x4*)(gvec + 4 * lane + 256 * j);
    unsigned char* ws = lws(P);
    bf16_t* dst = (bf16_t*)(ws + (g == 0 ? WS_H : WS_H1)); bf16_t* ped = (bf16_t*)(ws + (g == 0 ? WS_PE : WS_PE1));
    for (int lr = gw; lr < nr; lr += NGW) {
        const float* src = xrow(P, g, lr);
        f32x4 v[4]; float s = 0.f;
#pragma unroll
        for (int j = 0; j < 4; ++j) { v[j] = *(const f32x4*)(src + 4 * lane + 256 * j); s += v[j][0] * v[j][0] + v[j][1] * v[j][1] + v[j][2] * v[j][2] + v[j][3] * v[j][3]; }
        const float rs = rsqrtf(wave_sum(s) * (1.f / 1024.f) + EPS);
#pragma unroll
        for (int j = 0; j < 4; ++j) { u32x2 w; w.x = pk2(v[j][0] * rs * gv[j][0], v[j][1] * rs * gv[j][1]); w.y = pk2(v[j][2] * rs * gv[j][2], v[j][3] * rs * gv[j][3]); *(u32x2*)(dst + (size_t)lr * 1024 + 4 * lane + 256 * j) = w; }
        const float* pr = lr < GROWS ? P.in[I_PP] + ((size_t)g * GROWS + lr) * PLE : P.in[I_PS] + (size_t)(lr - GROWS) * PLE;
        const f32x4 pv = *(const f32x4*)(pr + 4 * lane); u32x2 w; w.x = pk2(pv[0], pv[1]); w.y = pk2(pv[2], pv[3]);
        *(u32x2*)(ped + (size_t)lr * PLE + 4 * lane) = w;
    }
}

__device__ __forceinline__ bf16_t* bcc_row(const Params& P, int g, int lr) {
    return lr < GROWS ? (bf16_t*)(P.out + O_YP + (size_t)g * GROWS * DM) + (size_t)lr * 1024 : (bf16_t*)(P.out + O_YS) + (size_t)(lr - GROWS) * 1024;
}
__device__ __forceinline__ void bc_prepass(const Params& P, int g, int wv) {
    const size_t gt = (size_t)lbid() * 512 + ltid_w(wv), GT = (size_t)gridDim.x * 512;
    unsigned char* ws = lws(P);
    const bf16_t* xbc = (const bf16_t*)(ws + WS_XBC);
    const size_t n = (size_t)(grows(g) / 8) * 128;
    for (size_t i = gt; i < n; i += GT) {
        const int rg = (int)(i / 128), c0 = (int)(i % 128) * 8, lr0 = rg * 8, ch = 2048 + c0;
        int t0, sb = 0; const bool smp = lr0 >= GROWS; if (smp) { sb = (lr0 - GROWS) >> 5; t0 = (lr0 - GROWS) & 31; } else t0 = lr0 & 2047;
        float w[5][8];
#pragma unroll
        for (int k = 0; k < 5; ++k) { const float* wp = (k < 4 ? P.in[I_CSW] + k * 3072 : P.in[I_CSB]) + ch; const f32x4 a = *(const f32x4*)wp, b2 = *(const f32x4*)(wp + 4);
            w[k][0] = a[0]; w[k][1] = a[1]; w[k][2] = a[2]; w[k][3] = a[3]; w[k][4] = b2[0]; w[k][5] = b2[1]; w[k][6] = b2[2]; w[k][7] = b2[3]; }
        float pa[8], pb[8], pc[8];
#pragma unroll
        for (int k = 0; k < 3; ++k) {
            float* dst = k == 0 ? pa : (k == 1 ? pb : pc);
            if (t0 > 0) unpack8(*(const u32x4*)(xbc + (size_t)(lr0 - 3 + k) * 3072 + ch), dst);
            else if (smp) { const float* cp = P.in[I_CSSM] + ((size_t)sb * 3 + k) * 3072 + ch; const f32x4 a = *(const f32x4*)cp, b2 = *(const f32x4*)(cp + 4); dst[0] = a[0]; dst[1] = a[1]; dst[2] = a[2]; dst[3] = a[3]; dst[4] = b2[0]; dst[5] = b2[1]; dst[6] = b2[2]; dst[7] = b2[3]; }
            else {
#pragma unroll
                for (int e = 0; e < 8; ++e) dst[e] = 0.f;
            }
        }
#pragma unroll
        for (int r = 0; r < 8; ++r) {
            float cur[8], o[8];
            unpack8(*(const u32x4*)(xbc + (size_t)(lr0 + r) * 3072 + ch), cur);
#pragma unroll
            for (int e = 0; e < 8; ++e) { o[e] = siluf_(w[4][e] + w[0][e] * pa[e] + w[1][e] * pb[e] + w[2][e] * pc[e] + w[3][e] * cur[e]); pa[e] = pb[e]; pb[e] = pc[e]; pc[e] = cur[e]; }
            *(u32x4*)(bcc_row(P, g, lr0 + r) + c0) = pack8(o);
        }
    }
}

#define MFMA16(a, b, c) __builtin_amdgcn_mfma_f32_16x16x32_bf16((a), (b), (c), 0, 0, 0)
#define VMWAIT0() asm volatile("s_waitcnt vmcnt(0)" ::: "memory")
constexpr int SSD_RAW = 105728, SSD_ZS = 148608;
__device__ __forceinline__ int ssd_chmap(int c0, int h, int grp) { return c0 < 64 ? h * 64 + c0 : (c0 < 192 ? 2048 + grp * 128 + (c0 - 64) : 2560 + grp * 128 + (c0 - 192)); }
__device__ __forceinline__ void ssd_item(const Params& P, LAS unsigned char* lds, int g, int item, int wv) {
    const int tid = ltid_w(wv), lane = tid & 63, wave = __builtin_amdgcn_readfirstlane(tid >> 6), fr = lane & 15, fq = lane >> 4;
    unsigned char* ws = lws(P);
    const bool smp = item >= 256;
    const int sq = smp ? (item - 256) >> 5 : item >> 5, h = item & 31, grp = h >> 3;
    const int lr0 = smp ? GROWS + sq * 32 : sq * 2048, L = smp ? 32 : 64, nch = smp ? 1 : 32;
    LAS bf16_t* Xt = (LAS bf16_t*)(lds);
    LAS bf16_t* Xwt = (LAS bf16_t*)(lds + 10240);
    LAS bf16_t* Bm = (LAS bf16_t*)(lds + 20480);
    LAS bf16_t* Bt = (LAS bf16_t*)(lds + 37888);
    LAS bf16_t* Cm = (LAS bf16_t*)(lds + 58368);
    LAS bf16_t* Gm = (LAS bf16_t*)(lds + 75776);
    LAS bf16_t* Hb = (LAS bf16_t*)(lds + 86016);
    LAS float* sacs = (LAS float*)(lds + 104704);
    LAS float* sdt = sacs + 64;
    LAS float* sred = sacs + 128;
    LAS unsigned char* rawb = lds + SSD_RAW;
    LAS bf16_t* Zs = (LAS bf16_t*)(lds + SSD_ZS);
    const float aneg = -__expf(P.in[I_ALOG][h]), dskip = P.in[I_DSKIP][h];
    const bf16_t* xbc = (const bf16_t*)(ws + WS_XBC);
    const float* dtp = (const float*)(ws + WS_DT);
    bf16_t* zb = (bf16_t*)(ws + WS_Z);
    float* ssq = (float*)(ws + WS_SSQ);
    LAS float* cw = (LAS float*)(lds + 103424);
    for (int i = tid; i < 5 * 64; i += 512) { const int k = i >> 6, cc = i & 63; cw[i] = k < 4 ? P.in[I_CSW][k * 3072 + h * 64 + cc] : P.in[I_CSB][h * 64 + cc]; }
    const bf16_t* bcc0 = bcc_row(P, g, 0);
    const int pbH = wave >> 1, nbH0 = 4 * (wave & 1);
    f32x4 Hacc[4];
#pragma unroll
    for (int tt = 0; tt < 4; ++tt) {
        Hacc[tt] = (f32x4){0.f, 0.f, 0.f, 0.f};
        if (smp) Hacc[tt] = *(const f32x4*)(P.in[I_SSM] + (((size_t)sq * 32 + h) * 64 + pbH * 16 + fr) * 128 + (nbH0 + tt) * 16 + 4 * fq);
        u32x2 w; w.x = pk2(Hacc[tt][0], Hacc[tt][1]); w.y = pk2(Hacc[tt][2], Hacc[tt][3]);
        *(LAS u32x2*)(Hb + (pbH * 16 + fr) * 136 + (nbH0 + tt) * 16 + 4 * fq) = w;
    }
#define SSD_RAW_DMA(cc) do { const int tokc0_ = lr0 + (cc) * L; _Pragma("unroll") for (int k_ = 0; k_ < 6; ++k_) { const int sb_ = (k_ * 8 + wave) * 64; if (sb_ < 2747) { const int s_ = sb_ + lane, row_ = s_ / 41, o_ = s_ - row_ * 41; \
        const bool ok_ = (s_ < 2747) && (o_ < 40) && ((cc) > 0 || row_ >= 3) && (row_ - 3 < L) && (o_ < 8 || row_ >= 3); \
        const int lrr_ = tokc0_ - 3 + row_; \
        const bf16_t* src_ = o_ < 8 ? xbc + (size_t)lrr_ * 3072 + h * 64 + o_ * 8 : (smp ? bcc_s : bcc0) + (size_t)(smp ? lrr_ - GROWS : lrr_) * 1024 + (o_ < 24 ? grp * 128 + (o_ - 8) * 8 : 512 + grp * 128 + (o_ - 24) * 8); \
        if (ok_) __builtin_amdgcn_global_load_lds((const unsigned*)src_, (LAS unsigned*)(rawb + sb_ * 16), 16, 0, 0); } } } while (0)
    const bf16_t* bcc_s = bcc_row(P, g, GROWS);
    SSD_RAW_DMA(0);
    if (tid < 120) {
        const int row = tid / 40, o = tid - row * 40; u32x4 w = (u32x4){0u, 0u, 0u, 0u};
        if (smp && o < 8) { const float* cp = P.in[I_CSSM] + ((size_t)sq * 3 + row) * 3072 + h * 64 + o * 8; const f32x4 a = *(const f32x4*)cp, b2 = *(const f32x4*)(cp + 4); float v[8] = {a[0], a[1], a[2], a[3], b2[0], b2[1], b2[2], b2[3]}; w = pack8(v); }
        *(LAS u32x4*)(rawb + (row * 41 + o) * 16) = w;
    }
    float dtn = lane < L ? dtp[(size_t)(lr0 + lane) * 32 + h] : 0.f;
    VMWAIT0(); __syncthreads();
    for (int c = 0; c < nch; ++c) {
        const int tok0 = lr0 + c * L;
        u32x2 zreg[2];
        { const int i_ = (wave >> 1) * 16 + fr;
#pragma unroll
          for (int tt = 0; tt < 2; ++tt) { zreg[tt] = (u32x2){0u, 0u}; if (i_ < L) zreg[tt] = *(const u32x2*)(zb + (size_t)(tok0 + i_) * 2048 + h * 64 + (2 * (wave & 1) + tt) * 16 + 4 * fq); } }
        const float dtl = dtn;
        if (c + 1 < nch) dtn = dtp[(size_t)(tok0 + L + lane) * 32 + h];
        float acs = dtl * aneg;
#pragma unroll
        for (int o = 1; o < 64; o <<= 1) { const float t = __shfl_up(acs, o); if (lane >= o) acs += t; }
        const float last = __shfl(acs, 63);
        if (wave == 0) { sacs[lane] = acs; sdt[lane] = dtl; if (c > 0 && lane < L) ssq[(size_t)(tok0 - L + lane) * 32 + h] = sred[lane] + sred[64 + lane]; }
        {
            const int j = lane, xo = wave, c0 = xo * 8;
            float v[8];
#pragma unroll
            for (int e = 0; e < 8; ++e) v[e] = cw[256 + c0 + e];
#pragma unroll
            for (int i = 0; i < 4; ++i) { float r[8]; unpack8(*(const LAS u32x4*)(rawb + ((j + i) * 41 + xo) * 16), r);
#pragma unroll
                for (int e = 0; e < 8; ++e) v[e] += cw[i * 64 + c0 + e] * r[e]; }
            const float wj = __expf(last - acs) * dtl;
#pragma unroll
            for (int e = 0; e < 8; ++e) { const float x = j < L ? siluf_(v[e]) : 0.f; Xt[(c0 + e) * 80 + j] = (bf16_t)(pk2(x, 0.f) & 0xffffu); Xwt[(c0 + e) * 80 + j] = (bf16_t)(pk2(x * wj, 0.f) & 0xffffu); }
#pragma unroll
            for (int k = 0; k < 4; ++k) {
                const int jj = lane, o2 = wave + 8 * k;
                u32x4 w = (u32x4){0u, 0u, 0u, 0u};
                if (jj < L) w = *(const LAS u32x4*)(rawb + ((jj + 3) * 41 + 8 + o2) * 16);
                if (o2 < 16) {
                    *(LAS u32x4*)(Bm + jj * 136 + o2 * 8) = w;
                    LAS bf16_t* bt = Bt + (o2 * 8) * 80 + jj;
                    bt[0 * 80] = (bf16_t)(w.x & 0xffffu); bt[1 * 80] = (bf16_t)(w.x >> 16); bt[2 * 80] = (bf16_t)(w.y & 0xffffu); bt[3 * 80] = (bf16_t)(w.y >> 16);
                    bt[4 * 80] = (bf16_t)(w.z & 0xffffu); bt[5 * 80] = (bf16_t)(w.z >> 16); bt[6 * 80] = (bf16_t)(w.w & 0xffffu); bt[7 * 80] = (bf16_t)(w.w >> 16);
                } else {
                    *(LAS u32x4*)(Cm + jj * 136 + (o2 - 16) * 8) = w;
                }
            }
        }
        asm volatile("s_waitcnt lgkmcnt(0)" ::: "memory"); __builtin_amdgcn_s_barrier(); asm volatile("" ::: "memory");
        if (c + 1 < nch) SSD_RAW_DMA(c + 1);
        const int ib = wave >> 1;
        const float acsi = sacs[ib * 16 + fr];
        f32x4 yin[2];
#pragma unroll
        for (int tt = 0; tt < 2; ++tt) {
            const int jb = 2 * (wave & 1) + tt;
            f32x4 cbv = (f32x4){0.f, 0.f, 0.f, 0.f};
            if (jb <= ib) {
#pragma unroll
                for (int ks = 0; ks < 4; ++ks) {
                    const bf16x8 a = *(const LAS bf16x8*)(Bm + (jb * 16 + fr) * 136 + ks * 32 + fq * 8);
                    const bf16x8 b2 = *(const LAS bf16x8*)(Cm + (ib * 16 + fr) * 136 + ks * 32 + fq * 8);
                    cbv = MFMA16(a, b2, cbv);
                }
                const int i = ib * 16 + fr;
#pragma unroll
                for (int e = 0; e < 4; ++e) { const int j = jb * 16 + 4 * fq + e; cbv[e] = (j <= i) ? cbv[e] * __expf(acsi - sacs[j]) * sdt[j] : 0.f; }
            }
            u32x2 w; w.x = pk2(cbv[0], cbv[1]); w.y = pk2(cbv[2], cbv[3]);
            *(LAS u32x2*)(Gm + (ib * 16 + fr) * 80 + jb * 16 + 4 * fq) = w;
            const int pb = jb;
            f32x4 y = (f32x4){0.f, 0.f, 0.f, 0.f};
#pragma unroll
            for (int ks = 0; ks < 4; ++ks) {
                const bf16x8 a = *(const LAS bf16x8*)(Hb + (pb * 16 + fr) * 136 + ks * 32 + fq * 8);
                const bf16x8 b2 = *(const LAS bf16x8*)(Cm + (ib * 16 + fr) * 136 + ks * 32 + fq * 8);
                y = MFMA16(a, b2, y);
            }
            yin[tt] = y;
        }
        asm volatile("s_waitcnt lgkmcnt(0)" ::: "memory"); __builtin_amdgcn_s_barrier(); asm volatile("" ::: "memory");
        {
            const int i = ib * 16 + fr; const float eai = __expf(acsi); float ss = 0.f;
#pragma unroll
            for (int tt = 0; tt < 2; ++tt) {
                const int pb = 2 * (wave & 1) + tt;
                f32x4 y = (f32x4){0.f, 0.f, 0.f, 0.f};
#pragma unroll
                for (int ks = 0; ks < 2; ++ks) {
                    const bf16x8 a = *(const LAS bf16x8*)(Xt + (pb * 16 + fr) * 80 + ks * 32 + fq * 8);
                    const bf16x8 b2 = *(const LAS bf16x8*)(Gm + (ib * 16 + fr) * 80 + ks * 32 + fq * 8);
                    y = MFMA16(a, b2, y);
                }
                if (i < L) {
                    const u32x2 zw = zreg[tt];
                    const float sz[4] = {siluf_(bflo(zw.x)), siluf_(bfhi(zw.x)), siluf_(bflo(zw.y)), siluf_(bfhi(zw.y))};
                    float o[4];
#pragma unroll
                    for (int e = 0; e < 4; ++e) { const float xs = bf2f(Xt[(pb * 16 + 4 * fq + e) * 80 + i]); o[e] = (y[e] + eai * yin[tt][e] + dskip * xs) * sz[e]; ss += o[e] * o[e]; }
                    u32x2 w; w.x = pk2(o[0], o[1]); w.y = pk2(o[2], o[3]);
                    *(u32x2*)(zb + (size_t)(tok0 + i) * 2048 + h * 64 + pb * 16 + 4 * fq) = w;
                }
            }
            ss += __shfl_xor(ss, 16); ss += __shfl_xor(ss, 32);
            if (fq == 0) sred[(wave & 1) * 64 + i] = ss;
        }
        {
            const float el = __expf(last);
#pragma unroll
            for (int tt = 0; tt < 4; ++tt) {
                Hacc[tt] = Hacc[tt] * el;
#pragma unroll
                for (int ks = 0; ks < 2; ++ks) {
                    const bf16x8 a = *(const LAS bf16x8*)(Bt + ((nbH0 + tt) * 16 + fr) * 80 + ks * 32 + fq * 8);
                    const bf16x8 b2 = *(const LAS bf16x8*)(Xwt + (pbH * 16 + fr) * 80 + ks * 32 + fq * 8);
                    Hacc[tt] = MFMA16(a, b2, Hacc[tt]);
                }
            }
        }
#pragma unroll
        for (int tt = 0; tt < 4; ++tt) { u32x2 w; w.x = pk2(Hacc[tt][0], Hacc[tt][1]); w.y = pk2(Hacc[tt][2], Hacc[tt][3]); *(LAS u32x2*)(Hb + (pbH * 16 + fr) * 136 + (nbH0 + tt) * 16 + 4 * fq) = w; }
        if (smp) { asm volatile("s_waitcnt vmcnt(0) lgkmcnt(0)" ::: "memory"); } else { asm volatile("s_waitcnt vmcnt(2) lgkmcnt(0)" ::: "memory"); }
        __builtin_amdgcn_s_barrier(); asm volatile("" ::: "memory");
    }
    VMWAIT0(); __syncthreads();
    if (wave == 0 && lane < L) ssq[(size_t)(lr0 + (nch - 1) * L + lane) * 32 + h] = sred[lane] + sred[64 + lane];
    float* so = smp ? P.out + O_SSMS + (((size_t)sq * 32 + h) * 64) * 128 : P.out + O_SSMP + ((((size_t)g * 8 + sq) * 32 + h) * 64) * 128;
#pragma unroll
    for (int tt = 0; tt < 4; ++tt) *(f32x4*)(so + (size_t)(pbH * 16 + fr) * 128 + (nbH0 + tt) * 16 + 4 * fq) = Hacc[tt];
}

__device__ __forceinline__ void attn_wave(bf16_t* qo, const bf16_t* Kh, const bf16_t* Vth, int VP, int qpos0, int kstart, int seq_len, int t_lo, const LAS float* tbl, int lane) {
    const int fr = lane & 15, fq = lane >> 4;
    bf16x8 qf[2][2];
#pragma unroll
    for (int qb = 0; qb < 2; ++qb)
#pragma unroll
        for (int ks = 0; ks < 2; ++ks) qf[qb][ks] = *(const bf16x8*)(qo + (size_t)(qb * 16 + fr) * 1024 + ks * 32 + fq * 8);
    f32x4 o[2][4];
#pragma unroll
    for (int qb = 0; qb < 2; ++qb)
#pragma unroll
        for (int d = 0; d < 4; ++d) o[qb][d] = (f32x4){0.f, 0.f, 0.f, 0.f};
    float mrun[2] = {-1e30f, -1e30f}, lsum[2] = {0.f, 0.f};
    bf16x8 kc[4][2];
    {
        const int kt0 = kstart + 64 * t_lo;
#pragma unroll
        for (int blk = 0; blk < 4; ++blk) { const bf16_t* kp = Kh + (size_t)((kt0 >> 4) + blk) * 1024 + fq * 128 + fr * 8; kc[blk][0] = *(const bf16x8*)kp; kc[blk][1] = *(const bf16x8*)(kp + 512); }
    }
    const float bc = tbl[256];
    s16x4 vlo[4][2], vhi[4][2];
    {
        const int kt0 = kstart + 64 * t_lo;
#pragma unroll
        for (int d = 0; d < 4; ++d)
#pragma unroll
            for (int ks = 0; ks < 2; ++ks) { const bf16_t* vp = Vth + ((size_t)((kt0 + 32 * ks + 4 * fq) >> 2) * 1024 + d * 16 + fr) * 4; vlo[d][ks] = *(const s16x4*)vp; vhi[d][ks] = *(const s16x4*)(vp + 4 * 1024 * 4); }
    }
    for (int t = t_lo; t < 9; ++t) {
        const int kt0 = kstart + 64 * t, kt1 = kstart + 64 * (t < 8 ? t + 1 : t);
        s16x4 vnl[4][2], vnh[4][2];
#pragma unroll
        for (int d = 0; d < 4; ++d)
#pragma unroll
            for (int ks = 0; ks < 2; ++ks) { const bf16_t* vp = Vth + ((size_t)((kt1 + 32 * ks + 4 * fq) >> 2) * 1024 + d * 16 + fr) * 4; vnl[d][ks] = *(const s16x4*)vp; vnh[d][ks] = *(const s16x4*)(vp + 4 * 1024 * 4); }
        bf16x8 kn[4][2];
#pragma unroll
        for (int blk = 0; blk < 4; ++blk) { const bf16_t* kp = Kh + (size_t)((kt1 >> 4) + blk) * 1024 + fq * 128 + fr * 8; kn[blk][0] = *(const bf16x8*)kp; kn[blk][1] = *(const bf16x8*)(kp + 512); }
        f32x4 s[2][4];
#pragma unroll
        for (int qb = 0; qb < 2; ++qb)
#pragma unroll
            for (int blk = 0; blk < 4; ++blk) { f32x4 z = (f32x4){0.f, 0.f, 0.f, 0.f}; z = MFMA16(kc[blk][0], qf[qb][0], z); s[qb][blk] = MFMA16(kc[blk][1], qf[qb][1], z); }
        const bool cst = (qpos0 - (kt0 + 63)) >= 128;
        const bool tail = (kt0 + 64) > seq_len;
        bf16x8 pbv[2][2];
#pragma unroll
        for (int qb = 0; qb < 2; ++qb) {
            const int qpos = qpos0 + qb * 16 + fr;
            float mx = -1e30f, cc;
            if (cst && !tail) {
#pragma unroll
                for (int blk = 0; blk < 4; ++blk) mx = fmaxf(fmaxf(mx, fmaxf(s[qb][blk][0], s[qb][blk][1])), fmaxf(s[qb][blk][2], s[qb][blk][3]));
                mx += bc; cc = bc;
            } else {
#pragma unroll
                for (int blk = 0; blk < 4; ++blk)
#pragma unroll
                    for (int e = 0; e < 4; ++e) {
                        const int kpos = kt0 + blk * 16 + 4 * fq + e;
                        int rel = qpos - kpos; rel = rel < -128 ? -128 : (rel > 128 ? 128 : rel);
                        float v = s[qb][blk][e] + tbl[rel + 128];
                        if (tail && kpos >= seq_len) v = -1e30f;
                        s[qb][blk][e] = v; mx = fmaxf(mx, v);
                    }
                cc = 0.f;
            }
            mx = fmaxf(mx, __shfl_xor(mx, 16)); mx = fmaxf(mx, __shfl_xor(mx, 32));
            const float mnew = fmaxf(mrun[qb], mx), sc = __builtin_amdgcn_exp2f(mrun[qb] - mnew);
            mrun[qb] = mnew; cc -= mnew;
            float ps = 0.f;
#pragma unroll
            for (int blk = 0; blk < 4; ++blk)
#pragma unroll
                for (int e = 0; e < 4; ++e) { const float p = __builtin_amdgcn_exp2f(s[qb][blk][e] + cc); s[qb][blk][e] = p; ps += p; }
            lsum[qb] = lsum[qb] * sc + ps;
            if (__any(sc != 1.f)) {
#pragma unroll
                for (int d = 0; d < 4; ++d) o[qb][d] = o[qb][d] * sc;
            }
#pragma unroll
            for (int ks = 0; ks < 2; ++ks) {
                u32x4 pw; pw.x = pk2(s[qb][2 * ks][0], s[qb][2 * ks][1]); pw.y = pk2(s[qb][2 * ks][2], s[qb][2 * ks][3]); pw.z = pk2(s[qb][2 * ks + 1][0], s[qb][2 * ks + 1][1]); pw.w = pk2(s[qb][2 * ks + 1][2], s[qb][2 * ks + 1][3]);
                pbv[qb][ks] = __builtin_bit_cast(bf16x8, pw);
            }
        }
#pragma unroll
        for (int ks = 0; ks < 2; ++ks)
#pragma unroll
            for (int d = 0; d < 4; ++d) {
                const bf16x8 a = (bf16x8){vlo[d][ks][0], vlo[d][ks][1], vlo[d][ks][2], vlo[d][ks][3], vhi[d][ks][0], vhi[d][ks][1], vhi[d][ks][2], vhi[d][ks][3]};
                o[0][d] = MFMA16(a, pbv[0][ks], o[0][d]); o[1][d] = MFMA16(a, pbv[1][ks], o[1][d]);
            }
#pragma unroll
        for (int blk = 0; blk < 4; ++blk) { kc[blk][0] = kn[blk][0]; kc[blk][1] = kn[blk][1]; }
#pragma unroll
        for (int d = 0; d < 4; ++d)
#pragma unroll
            for (int ks = 0; ks < 2; ++ks) { vlo[d][ks] = vnl[d][ks]; vhi[d][ks] = vnh[d][ks]; }
    }
#pragma unroll
    for (int qb = 0; qb < 2; ++qb) {
        float l = lsum[qb]; l += __shfl_xor(l, 16); l += __shfl_xor(l, 32);
        const float inv = 1.f / l;
#pragma unroll
        for (int d = 0; d < 4; ++d) { u32x2 w; w.x = pk2(o[qb][d][0] * inv, o[qb][d][1] * inv); w.y = pk2(o[qb][d][2] * inv, o[qb][d][3] * inv); *(u32x2*)(qo + (size_t)(qb * 16 + fr) * 1024 + d * 16 + 4 * fq) = w; }
    }
}

__device__ __forceinline__ void mixer_phase(const Params& P, LAS unsigned char* lds, int g, int wv) {
    const int tid = ltid_w(wv), lane = tid & 63, wave = __builtin_amdgcn_readfirstlane(tid >> 6);
    unsigned char* ws = lws(P);
    const int nssd = g == 0 ? 256 : 512;
    for (int it = lbid(); it < nssd; it += gridDim.x) { ssd_item(P, lds, g, it, wv); __syncthreads(); }
    LAS float* tbl = (LAS float*)lds;
    for (int i = tid; i < 16 * 257; i += 512) tbl[i] = P.in[I_REL][i] * LOG2E;
    __syncthreads();
    bf16_t* q = (bf16_t*)(ws + WS_Q);
    const int nblk = 8 * 32 * 4 + (g == 1 ? 16 : 0);
    for (int bu = lbid(); bu < nblk; bu += gridDim.x) {
        if (bu < 1024) {
            const int bl = bu >> 7, c = (bu >> 2) & 31, h = (bu & 3) * 4 + (wave >> 1), half = wave & 1;
            const int qpos0 = c * 64 + half * 32;
            attn_wave(q + ((size_t)bl * 2048 + qpos0) * 1024 + h * 64, (const bf16_t*)(ws + WS_K) + ((size_t)bl * 16 + h) * 2048 * 64,
                      (const bf16_t*)(ws + WS_VT) + (size_t)bl * 2048 * 1024 + h * 64 * 4, 2048, qpos0, c * 64 - 512, 2048, c < 8 ? 8 - c : 0, tbl + h * 257, lane);
        } else {
            const int wi = (bu - 1024) * 8 + wave, sb = wi >> 4, h = wi & 15;
            attn_wave(q + ((size_t)GROWS + sb * 32) * 1024 + h * 64, (const bf16_t*)(ws + WS_KS) + ((size_t)sb * 16 + h) * 576 * 64,
                      (const bf16_t*)(ws + WS_VTS) + (size_t)sb * 576 * 1024 + h * 64 * 4, 576, 512, 0, 544, 0, tbl + h * 257, lane);
        }
    }
}

__device__ __forceinline__ void sg_kloop(f32x4 (&acc)[4], const bf16_t* A, const bf16_t* Bt, int K, int row0, int col0, int wave, int fr, int fq) {
    const int ksub = K >> 3, k0 = wave * ksub;
    const bf16_t* ap = A + (size_t)(row0 + fr) * K + k0 + fq * 8;
    const bf16_t* bp = Bt + (size_t)(col0 + fr) * K + k0 + fq * 8;
    if (ksub >= 128) {
        for (int kk = 0; kk < ksub; kk += 128) {
            bf16x8 a[4], bq[4][4];
#pragma unroll
            for (int s = 0; s < 4; ++s) { a[s] = *(const bf16x8*)(ap + kk + 32 * s);
#pragma unroll
                for (int t = 0; t < 4; ++t) bq[s][t] = *(const bf16x8*)(bp + (size_t)(16 * t) * K + kk + 32 * s); }
#pragma unroll
            for (int s = 0; s < 4; ++s)
#pragma unroll
                for (int t = 0; t < 4; ++t) acc[t] = MFMA16(bq[s][t], a[s], acc[t]);
        }
    } else {
        for (int kk = 0; kk < ksub; kk += 32) {
            const bf16x8 a = *(const bf16x8*)(ap + kk);
#pragma unroll
            for (int t = 0; t < 4; ++t) { const bf16x8 bq = *(const bf16x8*)(bp + (size_t)(16 * t) * K + kk); acc[t] = MFMA16(bq, a, acc[t]); }
        }
    }
}
__device__ __forceinline__ void sg_reduce(f32x4 (&acc)[4], LAS float* red, int wave, int lane) {
    if (wave > 0) {
#pragma unroll
        for (int t = 0; t < 4; ++t)
#pragma unroll
            for (int e = 0; e < 4; ++e) red[((wave - 1) * 16 + t * 4 + e) * 64 + lane] = acc[t][e];
    }
    __syncthreads();
    if (wave == 0) {
#pragma unroll
        for (int w = 0; w < 7; ++w)
#pragma unroll
            for (int t = 0; t < 4; ++t)
#pragma unroll
                for (int e = 0; e < 4; ++e) acc[t][e] += red[(w * 16 + t * 4 + e) * 64 + lane];
    }
    __syncthreads();
}
enum { SM_AB = 0, SM_OUT, SM_UP, SM_DOWN, SM_PLE };
__device__ __forceinline__ void sample_stage(const Params& P, LAS unsigned char* lds, int mode, int wv) {
    const int tid = ltid_w(wv), lane = tid & 63, wave = __builtin_amdgcn_readfirstlane(tid >> 6), fr = lane & 15, fq = lane >> 4;
    unsigned char* ws = lws(P);
    LAS float* red = (LAS float*)lds;
    const int ncb = mode == SM_UP ? 96 : 16, ntask = 16 * ncb;
    for (int task = lbid(); task < ntask; task += gridDim.x) {
        const int rb = task / ncb, cb = task - rb * ncb, row0 = rb * 16, col0 = cb * 64;
        f32x4 acc[4], acc2[4];
#pragma unroll
        for (int t = 0; t < 4; ++t) { acc[t] = (f32x4){0.f, 0.f, 0.f, 0.f}; acc2[t] = (f32x4){0.f, 0.f, 0.f, 0.f}; }
        if (mode == SM_AB) {
            sg_kloop(acc, (const bf16_t*)(ws + WS_Q) + (size_t)GROWS * 1024, (const bf16_t*)(ws + WS_WAT), 1024, row0, col0, wave, fr, fq);
            sg_kloop(acc2, (const bf16_t*)(ws + WS_Z) + (size_t)GROWS * 2048, (const bf16_t*)(ws + WS_WBT), 2048, row0, col0, wave, fr, fq);
        } else if (mode == SM_OUT) {
            sg_kloop(acc, (const bf16_t*)(ws + WS_H) + (size_t)GROWS * 1024, (const bf16_t*)(ws + WS_WOT), 1024, row0, col0, wave, fr, fq);
        } else if (mode == SM_UP) {
            sg_kloop(acc, (const bf16_t*)(ws + WS_XB) + (size_t)GROWS * 1024, (const bf16_t*)(ws + WS_WUT), 1024, row0, col0, wave, fr, fq);
        } else if (mode == SM_DOWN) {
            sg_kloop(acc, (const bf16_t*)(ws + WS_GA) + (size_t)GROWS * 3072, (const bf16_t*)(ws + WS_WDT), 3072, row0, col0, wave, fr, fq);
        } else {
            sg_kloop(acc, (const bf16_t*)(ws + WS_XB) + (size_t)GROWS * 1024, (const bf16_t*)(ws + WS_WGT), 1024, row0, col0, wave, fr, fq);
            sg_kloop(acc2, (const bf16_t*)(ws + WS_PE1) + (size_t)GROWS * 256, (const bf16_t*)(ws + WS_WPT), 256, row0, col0, wave, fr, fq);
        }
        sg_reduce(acc, red, wave, lane);
        if (mode == SM_AB || mode == SM_PLE) sg_reduce(acc2, red, wave, lane);
        if (wave == 0) {
            const int r = row0 + fr, lr = GROWS + r;
            float rs = 1.f;
            if (mode == SM_AB) { const f32x4* sp = (const f32x4*)((const float*)(ws + WS_SSQ) + (size_t)lr * 32); float s = 0.f;
#pragma unroll
                for (int q4 = 0; q4 < 8; ++q4) { const f32x4 x = sp[q4]; s += (x[0] + x[1]) + (x[2] + x[3]); }
                rs = rsqrtf(s * (1.f / 2048.f) + EPS); }
            if (mode == SM_UP || mode == SM_PLE) { const f32x4* sp = (const f32x4*)((const float*)(ws + WS_SSX) + (size_t)lr * 16); float s = 0.f;
#pragma unroll
                for (int q4 = 0; q4 < 4; ++q4) { const f32x4 x = sp[q4]; s += (x[0] + x[1]) + (x[2] + x[3]); }
                rs = rsqrtf(s * (1.f / 1024.f) + EPS); }
            float ss = 0.f;
#pragma unroll
            for (int t = 0; t < 4; ++t) {
                const int c = col0 + 16 * t + 4 * fq;
                if (mode == SM_AB) {
                    const u32x2 ga = *(const u32x2*)((const bf16_t*)(ws + WS_GT) + (size_t)lr * 2048 + c), gb = *(const u32x2*)((const bf16_t*)(ws + WS_GT) + (size_t)lr * 2048 + 1024 + c);
                    const float g0[4] = {bflo(ga.x), bfhi(ga.x), bflo(ga.y), bfhi(ga.y)}, g1[4] = {bflo(gb.x), bfhi(gb.x), bflo(gb.y), bfhi(gb.y)};
                    float v[4];
#pragma unroll
                    for (int e = 0; e < 4; ++e) v[e] = bf2f((bf16_t)(pk2(g0[e] * acc[t][e], 0.f) & 0xffffu)) + g1[e] * rs * acc2[t][e];
                    u32x2 w; w.x = pk2(v[0], v[1]); w.y = pk2(v[2], v[3]);
                    *(u32x2*)((bf16_t*)(ws + WS_H) + (size_t)lr * 1024 + c) = w;
                } else if (mode == SM_OUT || mode == SM_DOWN) {
                    bf16_t* xbp = (bf16_t*)(ws + WS_XB) + (size_t)lr * 1024 + c;
                    f32x4 x;
                    if (mode == SM_OUT) x = *(const f32x4*)(P.in[I_XS] + (size_t)r * DM + c);
                    else { const u32x2 xw = *(const u32x2*)xbp; x = (f32x4){bflo(xw.x), bfhi(xw.x), bflo(xw.y), bfhi(xw.y)}; }
                    const f32x4 v = (f32x4){x[0] + acc[t][0], x[1] + acc[t][1], x[2] + acc[t][2], x[3] + acc[t][3]};
                    u32x2 w; w.x = pk2(v[0], v[1]); w.y = pk2(v[2], v[3]);
                    *(u32x2*)xbp = w;
                    ss += (v[0] * v[0] + v[1] * v[1]) + (v[2] * v[2] + v[3] * v[3]);
                } else if (mode == SM_UP) {
                    const f32x4 v = acc[t] * rs;
                    u32x2 w; w.x = pk2(v[0], v[1]); w.y = pk2(v[2], v[3]);
                    *(u32x2*)((bf16_t*)(ws + WS_U) + (size_t)lr * 6144 + c) = w;
                    const int bq = r >> 5, tq = r & 31;
                    if (tq >= 30) *(f32x4*)(P.out + O_CFS + ((size_t)bq * 2 + (tq - 30)) * 6144 + c) = v;
                } else {
                    float* yr = P.out + O_YS + (size_t)r * DM + c;
                    const u32x2 xw = *(const u32x2*)((const bf16_t*)(ws + WS_XB) + (size_t)lr * 1024 + c);
                    const f32x4 x = (f32x4){bflo(xw.x), bfhi(xw.x), bflo(xw.y), bfhi(xw.y)};
                    f32x4 v;
#pragma unroll
                    for (int e = 0; e < 4; ++e) v[e] = x[e] + bf2f((bf16_t)(pk2(sigmoidf_(acc[t][e] * rs), 0.f) & 0xffffu)) * acc2[t][e];
                    *(f32x4*)yr = v;
                }
            }
            if (mode == SM_OUT || mode == SM_DOWN) {
                ss += __shfl_xor(ss, 16); ss += __shfl_xor(ss, 32);
                if (fq == 0) {
                    ((float*)(ws + WS_SSX))[(size_t)lr * 16 + cb] = ss;
                }
            }
        }
    }
    asm volatile("s_waitcnt vmcnt(0)" ::: "memory"); __syncthreads();
}

__device__ __forceinline__ float gelu_tanh(float x) { const float u = 0.7978845608028654f * (x + 0.044715f * x * x * x); return x * __builtin_amdgcn_rcpf(1.f + __builtin_amdgcn_exp2f(-2.f * LOG2E * u)); }
__device__ __forceinline__ void ew_phase(const Params& P, int g, int wv) {
    const size_t gt = (size_t)lbid() * 512 + ltid_w(wv), GT = (size_t)gridDim.x * 512;
    unsigned char* ws = lws(P);
    const bf16_t* ub = (const bf16_t*)(ws + WS_U); bf16_t* ga = (bf16_t*)(ws + WS_GA);
    const size_t n = (size_t)(grows(g) / 8) * 384;
    for (size_t i = gt; i < n; i += GT) {
        const int rg = (int)(i / 384), c0 = (int)(i % 384) * 8, lr0 = rg * 8;
        int t0, sb = 0; const bool smp = lr0 >= GROWS; if (smp) { sb = (lr0 - GROWS) >> 5; t0 = (lr0 - GROWS) & 31; } else t0 = lr0 & 2047;
        float w[2][4][8];
#pragma unroll
        for (int hf = 0; hf < 2; ++hf)
#pragma unroll
            for (int k = 0; k < 4; ++k) { const float* wp = (k < 3 ? P.in[I_FCW] + k * 6144 : P.in[I_FCB]) + hf * 3072 + c0; const f32x4 a = *(const f32x4*)wp, b2 = *(const f32x4*)(wp + 4);
                w[hf][k][0] = a[0]; w[hf][k][1] = a[1]; w[hf][k][2] = a[2]; w[hf][k][3] = a[3]; w[hf][k][4] = b2[0]; w[hf][k][5] = b2[1]; w[hf][k][6] = b2[2]; w[hf][k][7] = b2[3]; }
        float pa[2][8], pb[2][8];
#pragma unroll
        for (int hf = 0; hf < 2; ++hf) {
            const int ch = hf * 3072 + c0;
#pragma unroll
            for (int k = 0; k < 2; ++k) {
                float* dst = k == 0 ? pa[hf] : pb[hf];
                if (t0 > 0) unpack8(*(const u32x4*)(ub + (size_t)(lr0 - 2 + k) * 6144 + ch), dst);
                else if (smp) { const float* cp = P.in[I_CFFN] + ((size_t)sb * 2 + k) * 6144 + ch; const f32x4 a = *(const f32x4*)cp, b2 = *(const f32x4*)(cp + 4); dst[0] = a[0]; dst[1] = a[1]; dst[2] = a[2]; dst[3] = a[3]; dst[4] = b2[0]; dst[5] = b2[1]; dst[6] = b2[2]; dst[7] = b2[3]; }
                else {
#pragma unroll
                    for (int e = 0; e < 8; ++e) dst[e] = 0.f;
                }
            }
        }
#pragma unroll
        for (int r = 0; r < 8; ++r) {
            float cur[2][8], res[2][8];
#pragma unroll
            for (int hf = 0; hf < 2; ++hf) {
                unpack8(*(const u32x4*)(ub + (size_t)(lr0 + r) * 6144 + hf * 3072 + c0), cur[hf]);
#pragma unroll
                for (int e = 0; e < 8; ++e) { res[hf][e] = w[hf][3][e] + w[hf][0][e] * pa[hf][e] + w[hf][1][e] * pb[hf][e] + w[hf][2][e] * cur[hf][e]; pa[hf][e] = pb[hf][e]; pb[hf][e] = cur[hf][e]; }
            }
            float o[8];
#pragma unroll
            for (int e = 0; e < 8; ++e) o[e] = gelu_tanh(res[0][e]) * res[1][e];
            *(u32x4*)(ga + (size_t)(lr0 + r) * 3072 + c0) = pack8(o);
        }
    }
}

#define XB_TMO      128
#define XB_XCNT(j)  (256  + 64 * (j))
#define XB_XSUB(j)  (1280 + 64 * (j))
#define XB_XGEN(j)  (2304 + 64 * (j))
#define XB_TOP      3328
#define XB_TOPGEN   3392
#define XCD_BAR_WORDS 3456
#define XB_SPIN_CAP (1u << 18)

__device__ __forceinline__ unsigned xb_ld(unsigned* p)              { return __hip_atomic_load(p, __ATOMIC_RELAXED, __HIP_MEMORY_SCOPE_AGENT); }
__device__ __forceinline__ unsigned xb_add(unsigned* p, unsigned v) { return __hip_atomic_fetch_add(p, v, __ATOMIC_RELAXED, __HIP_MEMORY_SCOPE_AGENT); }
__device__ __forceinline__ unsigned xb_xcc_id() { return (unsigned)__builtin_amdgcn_s_getreg((3 << 11) | 20) & 0xFu; }
#define XB_SPIN(cond, bar) do { unsigned _sp = 0; while (cond) { __builtin_amdgcn_s_sleep(1); \
    if ((++_sp & 255u) == 0u) { if (xb_ld(&(bar)[XB_TMO])) break; if (_sp > XB_SPIN_CAP) { atomicAdd(&(bar)[XB_TMO], 1u); break; } } } } while (0)

struct XcdBarrier {
    unsigned* bar; unsigned x;
    volatile LAS unsigned* st;
};

__device__ __forceinline__ XcdBarrier xcd_barrier_post(unsigned* bar, volatile LAS unsigned* st, int tid_) {
    XcdBarrier b; b.bar = bar; b.x = xb_xcc_id(); b.st = st;
    if (tid_ == 0) (void)xb_add(&bar[XB_XCNT(b.x)], 1u);
    return b;
}
__device__ __forceinline__ void xcd_barrier_complete(unsigned* bar, unsigned x, unsigned& nloc, unsigned& nx) {
    const unsigned G = gridDim.x * gridDim.y * gridDim.z;
    unsigned sum, cnt, mine, sp = 0u;
    for (;;) {
        sum = 0u; cnt = 0u; mine = 0u;
#pragma unroll
        for (unsigned j = 0; j < 16; ++j) { const unsigned c = xb_ld(&bar[XB_XCNT(j)]); sum += c; cnt += (c > 0u) ? 1u : 0u; mine = (j == x) ? c : mine; }
        if (sum == G) break;
        __builtin_amdgcn_s_sleep(1);
        if ((++sp & 255u) == 0u) { if (xb_ld(&bar[XB_TMO])) break; if (sp > XB_SPIN_CAP) { atomicAdd(&bar[XB_TMO], 1u); break; } }
    }
    nloc = mine > 0u ? mine : 1u; nx = cnt > 0u ? cnt : 1u;
}

__device__ __forceinline__ void xcd_barrier(const XcdBarrier& b, int tid_) {
    asm volatile("s_waitcnt vmcnt(0)" ::: "memory");
    __syncthreads();
    if (tid_ == 0) {
        unsigned* bar = b.bar;
        __builtin_amdgcn_s_waitcnt(0);
        unsigned nloc = b.st[0], nx = b.st[1];
        if (nloc == 0u) { xcd_barrier_complete(bar, b.x, nloc, nx); b.st[0] = nloc; b.st[1] = nx; }
        const unsigned old = xb_add(&bar[XB_XSUB(b.x)], 1u);
        const unsigned gen = old / nloc;
        if (old + 1u == (gen + 1u) * nloc) {
            __builtin_amdgcn_fence(__ATOMIC_RELEASE, "agent");
            asm volatile("s_waitcnt vmcnt(0)" ::: "memory");
            const unsigned og = xb_add(&bar[XB_TOP], 1u);
            const unsigned tg = og / nx;
            if (og + 1u == (tg + 1u) * nx) xb_add(&bar[XB_TOPGEN], 1u);
            else XB_SPIN(xb_ld(&bar[XB_TOPGEN]) == tg, bar);
            __builtin_amdgcn_fence(__ATOMIC_ACQUIRE, "agent");
            xb_add(&bar[XB_XGEN(b.x)], 1u);
            asm volatile("s_waitcnt vmcnt(0)" ::: "memory");
        } else {
            XB_SPIN(xb_ld(&bar[XB_XGEN(b.x)]) == gen, bar);
            __builtin_amdgcn_fence(__ATOMIC_ACQUIRE, "agent");
            asm volatile("s_waitcnt vmcnt(0)" ::: "memory");
        }
    }
    __syncthreads();
}


constexpr int NPHASE = 19;
__device__ __forceinline__ void gbar(unsigned* ctr, unsigned target, int tid) {
    asm volatile("s_waitcnt vmcnt(0)" ::: "memory");
    __syncthreads();
    if (tid == 0) {
        __builtin_amdgcn_fence(__ATOMIC_RELEASE, "agent");
        asm volatile("s_waitcnt vmcnt(0)" ::: "memory");
        __hip_atomic_fetch_add(ctr, 1u, __ATOMIC_RELAXED, __HIP_MEMORY_SCOPE_AGENT);
        while (__hip_atomic_load(ctr, __ATOMIC_RELAXED, __HIP_MEMORY_SCOPE_AGENT) < target) __builtin_amdgcn_s_sleep(1);
        __builtin_amdgcn_fence(__ATOMIC_ACQUIRE, "agent");
        asm volatile("s_waitcnt vmcnt(0)" ::: "memory");
    }
    __syncthreads();
}
#define PH_IN(k) (P.ph_lo <= (k) && (k) < P.ph_hi)
#define PH_SYNC(k) do { if (PH_IN(k) && PH_IN((k) + 1)) { xcd_barrier(xbar, ltid_w(wv)); } } while (0)
#define WSB(off) ((const bf16_t*)(lws(P) + (off)))
#define GROUP_PHASES(g, base, M) \
    if (PH_IN(base + 0)) run_gemm(lds, P, M_IN, g, WSB(g == 0 ? WS_H : WS_H1), WSB(WS_W1T), M, NINP, 1024, wv); PH_SYNC(base + 0); \
    if (PH_IN(base + 1)) bc_prepass(P, g, wv); PH_SYNC(base + 1); \
    if (PH_IN(base + 2)) mixer_phase(P, lds, g, wv); PH_SYNC(base + 2); \
    if (PH_IN(base + 3)) { if (g == 1) sample_stage(P, lds, SM_AB, wv); run_gemm(lds, P, M_PA, g, WSB(WS_Q), WSB(WS_WAT), GROWS, 1024, 1024, wv); run_gemm(lds, P, M_PB, g, WSB(WS_Z), WSB(WS_WBT), GROWS, 1024, 2048, wv); } PH_SYNC(base + 3); \
    if (PH_IN(base + 4)) { if (g == 1) sample_stage(P, lds, SM_OUT, wv); run_gemm(lds, P, M_OUT, g, WSB(WS_H), WSB(WS_WOT), GROWS, 1024, 1024, wv); } PH_SYNC(base + 4); \
    if (PH_IN(base + 5)) { if (g == 1) sample_stage(P, lds, SM_UP, wv); run_gemm(lds, P, M_UP, g, WSB(WS_XB), WSB(WS_WUT), GROWS, 6144, 1024, wv); } PH_SYNC(base + 5); \
    if (PH_IN(base + 6)) ew_phase(P, g, wv); PH_SYNC(base + 6); \
    if (PH_IN(base + 7)) { if (g == 1) sample_stage(P, lds, SM_DOWN, wv); run_gemm(lds, P, M_DOWN, g, WSB(WS_GA), WSB(WS_WDT), GROWS, 1024, 3072, wv); } PH_SYNC(base + 7); \
    if (PH_IN(base + 8)) { if (g == 1) sample_stage(P, lds, SM_PLE, wv); run_gemm(lds, P, M_PG, g, WSB(WS_XB), WSB(WS_WGT), GROWS, 1024, 1024, wv); run_gemm(lds, P, M_PLE, g, WSB(g == 0 ? WS_PE : WS_PE1), WSB(WS_WPT), GROWS, 1024, 256, wv); }
__global__ void __launch_bounds__(512, 2) fwd_kernel(Params P) {
    extern __shared__ __attribute__((aligned(16))) unsigned char lds_raw[];
    LAS unsigned char* lds = (LAS unsigned char*)lds_raw;
    cg::grid_group grid = cg::this_grid();
    int wv = __builtin_amdgcn_readfirstlane(threadIdx.x >> 6); asm volatile("" : "+s"(wv));
    if (P.ph_hi - P.ph_lo > 1) grid.sync();
    volatile LAS unsigned* xst = (volatile LAS unsigned*)(lds + 157184);
    { const int t0_ = ltid_w(wv); if (t0_ < 2) xst[t0_] = 0u; __syncthreads(); }
    XcdBarrier xbar = xcd_barrier_post((unsigned*)(lws(P) + 1024), xst, ltid_w(wv));
    if (PH_IN(0)) { prologue(P, lds, wv); norm_pass(P, 0, wv); norm_pass(P, 1, wv); }
    PH_SYNC(0);
    GROUP_PHASES(0, 1, GROWS)
    PH_SYNC(9);
    GROUP_PHASES(1, 10, TMAX)
}

#ifndef MULTI_LAUNCH
#define MULTI_LAUNCH 0
#endif
#ifdef DBG_SRC
__global__ void dbg_dump(const unsigned short* src, float* dst, size_t n) { for (size_t i = (size_t)blockIdx.x * blockDim.x + threadIdx.x; i < n; i += (size_t)gridDim.x * blockDim.x) dst[i] = bf2f(src[i]); }
#endif
extern "C" void kernel_launch(void* const* d_in, const int* in_sizes, int n_in, void* d_out, int out_size, void* d_ws, size_t ws_size, hipStream_t stream) {
    static int grid = 0;
    if (grid == 0) {
        if (n_in != 32 || ws_size < WS_END) { fprintf(stderr, "kernel_launch: unexpected n_in %d / ws_size %zu (need %zu)\n", n_in, ws_size, (size_t)WS_END); grid = -1; return; }
        int dev = 0, cus = 0, per_cu = 0;
        hipGetDevice(&dev); hipDeviceGetAttribute(&cus, hipDeviceAttributeMultiprocessorCount, dev);
        if (hipFuncSetAttribute((const void*)fwd_kernel, hipFuncAttributeMaxDynamicSharedMemorySize, LDS_BYTES) != hipSuccess) { fprintf(stderr, "hipFuncSetAttribute failed\n"); grid = -1; return; }
        if (hipOccupancyMaxActiveBlocksPerMultiprocessor(&per_cu, (const void*)fwd_kernel, 512, LDS_BYTES) != hipSuccess || per_cu < 1) { fprintf(stderr, "occupancy query: %d\n", per_cu); per_cu = 1; }
        (void)hipGetLastError();
        grid = cus * per_cu;
    }
    if (grid < 0) return;
    Params p{};
    for (int i = 0; i < 32; ++i) p.in[i] = (const float*)d_in[i];
    p.out = (float*)d_out; p.ws = (unsigned char*)d_ws;
#if MULTI_LAUNCH
#ifndef DBG_HI
#define DBG_HI NPHASE
#endif
    for (int ph = 0; ph < DBG_HI; ++ph) { p.ph_lo = ph; p.ph_hi = ph + 1; hipLaunchKernelGGL(fwd_kernel, dim3(grid), dim3(512), LDS_BYTES, stream, p); }
#ifdef DBG_SRC
    hipLaunchKernelGGL(dbg_dump, dim3(2048), dim3(256), 0, stream, (const unsigned short*)((unsigned char*)d_ws + (DBG_SRC)), (float*)d_out, (size_t)(DBG_N));
#endif
#else
    p.ph_lo = 0; p.ph_hi = NPHASE;
    (void)hipMemsetAsync(d_ws, 0, 16384, stream);
    void* args[] = {&p};
    hipError_t e = hipLaunchCooperativeKernel((const void*)fwd_kernel, dim3(grid), dim3(512), args, LDS_BYTES, stream);
    if (e != hipSuccess) fprintf(stderr, "cooperative launch failed: %s (grid %d)\n", hipGetErrorString(e), grid);
#endif
}
```

```cpp
#include <hip/hip_runtime.h>
#include <hip/hip_cooperative_groups.h>
#include <cstdio>
#include <cstdint>
namespace cg = cooperative_groups;
namespace pg8 {
#define PG8_LAS __attribute__((address_space(3)))
typedef unsigned short bf16_t;
typedef short bf16x8 __attribute__((ext_vector_type(8)));
typedef float f32x4 __attribute__((ext_vector_type(4)));
typedef unsigned u32x4 __attribute__((ext_vector_type(4)));
constexpr int BM = 256, BK = 64, HALF = 128, HTB = HALF * BK * 2  , STAGE_BYTES = 8 * HTB, NXCD = 8, WGM = 8;

__host__ __device__ __forceinline__ int lds_byte(int r, int c) { const int st = (r >> 4) * 2 + (c >> 5), rr = r & 15, cc = c & 31, ob = rr * 64 + cc * 2; return st * 1024 + (ob ^ (((ob >> 9) & 1) << 5)); }
__host__ __device__ __forceinline__ void stage_rc(int b, int& R, int& C) { const int st = b / 1024, sb = b % 1024, swz = sb ^ (((sb >> 9) & 1) << 5); R = (st >> 1) * 16 + swz / 64; C = (st & 1) * 32 + (swz % 64) / 2; }
__host__ __device__ __forceinline__ int perm32(int rho) { const int n = rho >> 4, i = rho & 15; return 8 * (i >> 2) + 4 * n + (i & 3); }

struct Unit { int pm, pn; };
struct Gemm { const bf16_t* A; const bf16_t* Bt; int M, N, K; };

struct StaticOrder {
    int nM, nN, nwg, G, c;
    __host__ __device__ __forceinline__ void init(int M, int N, int G_, int c_) { nM = M / BM; nN = N / BM; nwg = nM * nN; G = G_; c = c_; }
    __host__ __device__ __forceinline__ bool next(int i, Unit& u) const {
        const long L = (long)i * G + c; if (L >= nwg) return false;
        int wgid = (int)L; { const int q = nwg / NXCD, r = nwg % NXCD, xcd = wgid % NXCD, off = wgid / NXCD; wgid = (xcd < r ? xcd * (q + 1) : r * (q + 1) + (xcd - r) * q) + off; }
        const int nig = WGM * nN, gid = wgid / nig, fm = gid * WGM, gsz = (nM - fm) < WGM ? (nM - fm) : WGM;
        u.pm = fm + ((wgid % nig) % gsz); u.pn = (wgid % nig) / gsz; return true;
    }
    __device__ __forceinline__ void a_ready(const Unit&) const {}
    __device__ __forceinline__ void done(const Unit&) const {}
};

__device__ __forceinline__ unsigned cvt_pk_bf16(float lo, float hi) { unsigned r; asm volatile("v_cvt_pk_bf16_f32 %0, %1, %2" : "=v"(r) : "v"(lo), "v"(hi)); return r; }
template <class Epi, class Sched, bool ALIGN_EPI = false, bool SP2 = false>
__device__ __forceinline__ void gemm_phase(PG8_LAS unsigned char* lds, const Gemm g, const Sched& S, const Epi& E, int tid_in) {
    int tid_l = tid_in; asm volatile("" : "+v"(tid_l)); const int tid = tid_l, wid = __builtin_amdgcn_readfirstlane(tid >> 6), lane = tid & 63, wr = wid >> 2, wc = wid & 3, fr = lane & 15, fq = lane >> 4;
    const int K = g.K, nt = K / BK;
    unsigned voffA[2], voffB[2];
#pragma unroll
    for (int i = 0; i < 2; ++i) { int R, C; stage_rc(tid * 16 + i * 8192, R, C); const int Rb = Epi::PERM ? ((R & ~31) + perm32(R & 31)) : R;
        voffA[i] = (unsigned)(R * K + C) * 2u; voffB[i] = (unsigned)(Rb * K + C) * 2u; }
    const size_t kstep = (size_t)(BK * 2);
    const size_t hstep = (size_t)HALF * K * 2;
    const size_t tstep = 2 * hstep;
    const unsigned ldsw = (unsigned)wid * 1024u;
    const int aoff = lds_byte(wr * 64 + fr, fq * 8), boff = lds_byte(wc * 32 + fr, fq * 8);
#define PG8_SA(b, h) (((b) * 2 + (h)) * HTB)
#define PG8_SB(b, h) ((4 + (b) * 2 + (h)) * HTB)
#define PG8_STAGE(bufoff, gbase, voff) do { _Pragma("unroll") for (int _i = 0; _i < 2; ++_i) \
        __builtin_amdgcn_global_load_lds((const unsigned*)((const char*)(gbase) + (voff)[_i]), (PG8_LAS unsigned*)(lds + (bufoff) + ldsw + _i * 8192), 16, 0, 0); } while (0)
#define PG8_LDA(dst, b, h) do { _Pragma("unroll") for (int m = 0; m < 4; ++m) _Pragma("unroll") for (int k = 0; k < 2; ++k) dst[m][k] = *(const PG8_LAS bf16x8*)(lds + PG8_SA(b, h) + aoff + m * 2048 + k * 1024); } while (0)
#define PG8_LDB(dst, b, h) do { _Pragma("unroll") for (int n = 0; n < 2; ++n) _Pragma("unroll") for (int k = 0; k < 2; ++k) dst[n][k] = *(const PG8_LAS bf16x8*)(lds + PG8_SB(b, h) + boff + n * 2048 + k * 1024); } while (0)
#define PG8_MMA(ai, bj, At, Bt) do { __builtin_amdgcn_s_setprio(1); _Pragma("unroll") for (int m = 0; m < 4; ++m) _Pragma("unroll") for (int n = 0; n < 2; ++n) _Pragma("unroll") for (int k = 0; k < 2; ++k) \
        acc[ai][bj][m][n] = __builtin_amdgcn_mfma_f32_16x16x32_bf16(Bt[n][k], At[m][k], acc[ai][bj][m][n], 0, 0, 0); __builtin_amdgcn_s_setprio(0); } while (0)
#define PG8_WAIT_V(n) asm volatile("s_waitcnt vmcnt(" #n ")" ::: "memory")
#define PG8_WAIT_L(n) asm volatile("s_waitcnt lgkmcnt(" #n ")" ::: "memory")
#define PG8_BAR __builtin_amdgcn_s_barrier()
#define PG8_SCHED __builtin_amdgcn_sched_barrier(0)
    Unit cur, nxt; int ui = 0;
    if (!S.next(0, cur)) return;
    f32x4 acc[2][2][4][2];
#pragma unroll
    for (int a = 0; a < 2; ++a)
#pragma unroll
        for (int b = 0; b < 2; ++b)
#pragma unroll
            for (int m = 0; m < 4; ++m)
#pragma unroll
                for (int n = 0; n < 2; ++n) acc[a][b][m][n] = (f32x4){0.f, 0.f, 0.f, 0.f};
    bf16x8 At[4][2], B0[2][2], B1[2][2];
    const char* cA = (const char*)g.A + (size_t)cur.pm * tstep; const char* cB = (const char*)g.Bt + (size_t)cur.pn * tstep;
    S.a_ready(cur);
    if constexpr (SP2) {
        PG8_STAGE(PG8_SB(0, 0), cB, voffB); PG8_STAGE(PG8_SB(0, 1), cB + hstep, voffB); PG8_STAGE(PG8_SA(0, 0), cA, voffA); PG8_STAGE(PG8_SA(0, 1), cA + hstep, voffA);
        if (wr == 1) PG8_BAR;
        PG8_WAIT_V(2); PG8_BAR;
        PG8_STAGE(PG8_SB(1, 0), cB + kstep, voffB); PG8_STAGE(PG8_SA(1, 0), cA + kstep, voffA); PG8_STAGE(PG8_SB(1, 1), cB + hstep + kstep, voffB);
        PG8_WAIT_V(6); PG8_BAR;
    } else {
        PG8_STAGE(PG8_SB(0, 0), cB, voffB); PG8_STAGE(PG8_SA(0, 0), cA, voffA); PG8_STAGE(PG8_SB(0, 1), cB + hstep, voffB); PG8_STAGE(PG8_SA(0, 1), cA + hstep, voffA);
        if (wr == 1) PG8_BAR;
        PG8_WAIT_V(4); PG8_BAR;
        PG8_STAGE(PG8_SB(1, 0), cB + kstep, voffB); PG8_STAGE(PG8_SA(1, 0), cA + kstep, voffA); PG8_STAGE(PG8_SB(1, 1), cB + hstep + kstep, voffB);
        PG8_WAIT_V(6); PG8_BAR;
    }
    for (;;) {
        const bool has_next = S.next(ui + 1, nxt);
        const char* nA = has_next ? (const char*)g.A + (size_t)nxt.pm * tstep : cA; const char* nB = has_next ? (const char*)g.Bt + (size_t)nxt.pn * tstep : cB;
        for (int t = 0; t < nt; t += 2) {
            const bool last = (t == nt - 2);
            const char* a1 = cA + (size_t)(t + 1) * kstep;
            const char* a2 = last ? nA : cA + (size_t)(t + 2) * kstep; const char* b2 = last ? nB : cB + (size_t)(t + 2) * kstep;
            const char* a3 = a2 + kstep; const char* b3 = b2 + kstep;
            if (last && has_next) S.a_ready(nxt);
            if constexpr (SP2) {
            PG8_LDB(B0, 0, 0); PG8_LDB(B1, 0, 1); PG8_SCHED; PG8_LDA(At, 0, 0); PG8_STAGE(PG8_SA(1, 1), a1 + hstep, voffA);
            PG8_WAIT_V(8); PG8_WAIT_L(0); PG8_BAR; PG8_MMA(0, 0, At, B0); PG8_MMA(0, 1, At, B1); PG8_BAR; PG8_SCHED;
            PG8_LDA(At, 0, 1); PG8_STAGE(PG8_SB(0, 0), b2, voffB); PG8_STAGE(PG8_SB(0, 1), b2 + hstep, voffB); PG8_STAGE(PG8_SA(0, 0), a2, voffA);
            PG8_WAIT_V(8); PG8_WAIT_L(0); PG8_BAR; PG8_MMA(1, 0, At, B0); PG8_MMA(1, 1, At, B1); PG8_BAR; PG8_SCHED;
            PG8_LDB(B0, 1, 0); PG8_LDB(B1, 1, 1); PG8_SCHED; PG8_LDA(At, 1, 0); PG8_STAGE(PG8_SA(0, 1), a2 + hstep, voffA);
            PG8_WAIT_V(8); PG8_WAIT_L(0); PG8_BAR; PG8_MMA(0, 0, At, B0); PG8_MMA(0, 1, At, B1); PG8_BAR; PG8_SCHED;
            PG8_LDA(At, 1, 1); PG8_STAGE(PG8_SB(1, 0), b3, voffB); PG8_STAGE(PG8_SB(1, 1), b3 + hstep, voffB); PG8_STAGE(PG8_SA(1, 0), a3, voffA);
            PG8_WAIT_V(8); PG8_WAIT_L(0); PG8_BAR; PG8_MMA(1, 0, At, B0); PG8_MMA(1, 1, At, B1); PG8_BAR; PG8_SCHED;
            } else {
            PG8_LDB(B0, 0, 0); PG8_SCHED; PG8_LDA(At, 0, 0); PG8_STAGE(PG8_SA(1, 1), a1 + hstep, voffA);
            PG8_WAIT_L(8); PG8_BAR; PG8_WAIT_L(0); PG8_MMA(0, 0, At, B0); PG8_BAR; PG8_SCHED;
            PG8_LDB(B1, 0, 1); PG8_STAGE(PG8_SB(0, 0), b2, voffB);
            PG8_BAR; PG8_WAIT_L(0); PG8_MMA(0, 1, At, B1); PG8_BAR;
            PG8_LDA(At, 0, 1); PG8_STAGE(PG8_SA(0, 0), a2, voffA);
            PG8_BAR; PG8_WAIT_L(0); PG8_MMA(1, 0, At, B0); PG8_BAR; PG8_SCHED;
            PG8_STAGE(PG8_SB(0, 1), b2 + hstep, voffB);
            PG8_WAIT_V(6); PG8_BAR; PG8_MMA(1, 1, At, B1); PG8_BAR;
            PG8_LDB(B0, 1, 0); PG8_SCHED; PG8_LDA(At, 1, 0); PG8_STAGE(PG8_SA(0, 1), a2 + hstep, voffA);
            PG8_WAIT_L(8); PG8_BAR; PG8_WAIT_L(0); PG8_MMA(0, 0, At, B0); PG8_BAR; PG8_SCHED;
            PG8_LDB(B1, 1, 1); PG8_STAGE(PG8_SB(1, 0), b3, voffB);
            PG8_BAR; PG8_WAIT_L(0); PG8_MMA(0, 1, At, B1); PG8_BAR;
            PG8_LDA(At, 1, 1); PG8_STAGE(PG8_SA(1, 0), a3, voffA);
            PG8_BAR; PG8_WAIT_L(0); PG8_MMA(1, 0, At, B0); PG8_BAR; PG8_SCHED;
            PG8_STAGE(PG8_SB(1, 1), b3 + hstep, voffB);
            PG8_WAIT_V(6); PG8_BAR; PG8_MMA(1, 1, At, B1); PG8_BAR;
            }
        }
        if constexpr (ALIGN_EPI) { if (wr == 0) PG8_BAR; }
        if constexpr (!Epi::AFTER_DRAIN) { E(acc, cur, wr, wc, fr, fq); S.done(cur); }
        if (!has_next) break;
#pragma unroll
        for (int a = 0; a < 2; ++a)
#pragma unroll
            for (int b = 0; b < 2; ++b)
#pragma unroll
                for (int m = 0; m < 4; ++m)
#pragma unroll
                    for (int n = 0; n < 2; ++n) acc[a][b][m][n] = (f32x4){0.f, 0.f, 0.f, 0.f};
        cur = nxt; cA = nA; cB = nB; ++ui;
        if constexpr (ALIGN_EPI) { if (wr == 1) PG8_BAR; }
    }
    PG8_WAIT_V(0);
    if constexpr (!ALIGN_EPI) { if (wr == 0) PG8_BAR; }
    PG8_BAR;
    if constexpr (Epi::AFTER_DRAIN) { E.fused(acc, cur, wr, wc, fr, fq, lds, wid, lane); S.done(cur); }
#undef PG8_SA
#undef PG8_SB
#undef PG8_STAGE
#undef PG8_LDA
#undef PG8_LDB
#undef PG8_MMA
#undef PG8_WAIT_V
#undef PG8_WAIT_L
#undef PG8_BAR
#undef PG8_SCHED
}
}

#define LAS __attribute__((address_space(3)))
typedef unsigned short bf16_t;
typedef short bf16x8 __attribute__((ext_vector_type(8)));
typedef short s16x4 __attribute__((ext_vector_type(4)));
typedef float f32x4 __attribute__((ext_vector_type(4)));
typedef unsigned u32x4 __attribute__((ext_vector_type(4)));
typedef unsigned u32x2 __attribute__((ext_vector_type(2)));

constexpr int DM = 1024, SEQ = 2048, NHA = 16, NHS = 32, CONVD = 3072, DFF = 3072, PLE = 256;
constexpr int NIN = 10272, NINP = 41 * 256;
constexpr int GROWS = 16384, TMAX = 16640;
constexpr float EPS = 1e-6f, LOG2E = 1.4426950408889634f, QSCALE = 0.125f * 1.4426950408889634f;

constexpr size_t O_YP = 0, O_YS = 33554432, O_KP = O_YS + 262144, O_VP = O_KP + 8388608, O_SSMP = O_VP + 8388608, O_CSP = O_SSMP + 4194304,
                 O_CFP = O_CSP + 147456, O_KS = O_CFP + 196608, O_VS = O_KS + 262144, O_SSMS = O_VS + 262144, O_CSS = O_SSMS + 2097152, O_CFS = O_CSS + 73728;

constexpr size_t al256(size_t x) { return (x + 255) & ~(size_t)255; }
constexpr size_t WS_W1T = 65536;
constexpr size_t WS_WAT = WS_W1T + (size_t)NINP * 1024 * 2;
constexpr size_t WS_WBT = WS_WAT + (size_t)1024 * 1024 * 2;
constexpr size_t WS_WOT = WS_WBT + (size_t)1024 * 2048 * 2;
constexpr size_t WS_WUT = WS_WOT + (size_t)1024 * 1024 * 2;
constexpr size_t WS_WDT = WS_WUT + (size_t)6144 * 1024 * 2;
constexpr size_t WS_WGT = WS_WDT + (size_t)1024 * 3072 * 2;
constexpr size_t WS_WPT = WS_WGT + (size_t)1024 * 1024 * 2;
constexpr size_t WS_KS  = WS_WPT + (size_t)1024 * 256 * 2;
constexpr size_t WS_VTS = WS_KS + (size_t)8 * 576 * 1024 * 2;
constexpr size_t WS_SSQ = WS_VTS + (size_t)8 * 576 * 1024 * 2;
constexpr size_t WS_SSX = WS_SSQ + al256((size_t)TMAX * 32 * 4);
constexpr size_t WS_H   = WS_SSX + al256((size_t)TMAX * 16 * 4);
constexpr size_t WS_Q   = WS_H + (size_t)TMAX * 1024 * 2;
constexpr size_t WS_K   = WS_Q + (size_t)TMAX * 1024 * 2;
constexpr size_t WS_VT  = WS_K + (size_t)TMAX * 1024 * 2;
constexpr size_t WS_Z   = WS_VT + (size_t)8 * 1024 * 2048 * 2;
constexpr size_t WS_XBC = WS_Z + (size_t)TMAX * 2048 * 2;
constexpr size_t WS_GT  = WS_XBC + (size_t)TMAX * 3072 * 2;
constexpr size_t WS_DT  = WS_GT + (size_t)TMAX * 2048 * 2;
constexpr size_t WS_PE  = WS_DT + (size_t)TMAX * 32 * 4;
constexpr size_t WS_PE1 = WS_PE + (size_t)TMAX * 256 * 2;
constexpr size_t WS_H1  = WS_PE1 + (size_t)TMAX * 256 * 2;
constexpr size_t WS_END = WS_H1 + (size_t)TMAX * 1024 * 2;
constexpr size_t WS_U   = WS_K;
constexpr size_t WS_GA  = WS_U + (size_t)TMAX * 6144 * 2;
constexpr size_t WS_ST  = WS_H;
constexpr size_t WS_XB  = WS_Q;
static_assert(WS_GA + (size_t)TMAX * 3072 * 2 <= WS_PE, "ffn overlay");
static_assert(WS_END <= (size_t)512 * 1024 * 1024, "ws budget");

constexpr int LDS_BYTES = 157696;

struct Params { const float* in[32]; float* out; unsigned char* ws; int ph_lo, ph_hi; };

enum { I_XP = 0, I_XS, I_CK, I_CV, I_SSM, I_CSSM, I_CFFN, I_PP, I_PS, I_GMIX, I_WIN, I_BGATE, I_GQ, I_GK, I_REL, I_CSW, I_CSB, I_DTB, I_ALOG, I_DSKIP, I_GSSM,
       I_WPA, I_WPB, I_WOUT, I_GFFN, I_WUP, I_FCW, I_FCB, I_WDOWN, I_GPLE, I_WPG, I_WPLE };

__device__ __forceinline__ int ltid_w(int wv) { int t = wv * 64 + (int)__builtin_amdgcn_mbcnt_hi(~0u, __builtin_amdgcn_mbcnt_lo(~0u, 0u)); asm volatile("" : "+v"(t)); return t; }
__device__ __forceinline__ int lbid() { int t = blockIdx.x; asm volatile("" : "+s"(t)); return t; }
__device__ __forceinline__ unsigned char* lws(const struct Params& P);
typedef float f32x2_t __attribute__((ext_vector_type(2))); typedef __bf16 bf16x2_t __attribute__((ext_vector_type(2)));
__device__ __forceinline__ unsigned pk2(float lo, float hi) { f32x2_t v = {lo, hi}; bf16x2_t r = __builtin_convertvector(v, bf16x2_t); return __builtin_bit_cast(unsigned, r); }
__device__ __forceinline__ float bf2f(unsigned short b) { return __uint_as_float(((unsigned)b) << 16); }
__device__ __forceinline__ float bflo(unsigned w) { return __uint_as_float(w << 16); }
__device__ __forceinline__ float bfhi(unsigned w) { return __uint_as_float(w & 0xffff0000u); }
__device__ __forceinline__ float sigmoidf_(float x) { return __builtin_amdgcn_rcpf(1.f + __builtin_amdgcn_exp2f(-LOG2E * x)); }
__device__ __forceinline__ float siluf_(float x) { return x * __builtin_amdgcn_rcpf(1.f + __builtin_amdgcn_exp2f(-LOG2E * x)); }
__device__ __forceinline__ float wave_sum(float v) {
#pragma unroll
    for (int o = 1; o < 64; o <<= 1) v += __shfl_xor(v, o);
    return v;
}
__device__ __forceinline__ u32x4 pack8(const float* v) { u32x4 w; w.x = pk2(v[0], v[1]); w.y = pk2(v[2], v[3]); w.z = pk2(v[4], v[5]); w.w = pk2(v[6], v[7]); return w; }
__device__ __forceinline__ void unpack8(u32x4 w, float* v) { v[0] = bflo(w.x); v[1] = bfhi(w.x); v[2] = bflo(w.y); v[3] = bfhi(w.y); v[4] = bflo(w.z); v[5] = bfhi(w.z); v[6] = bflo(w.w); v[7] = bfhi(w.w); }

__device__ __forceinline__ unsigned char* lws(const Params& P) { int z = 0; asm volatile("" : "+s"(z)); return P.ws + z; }
__device__ __forceinline__ const float* xrow(const Params& P, int g, int lr) { return lr < GROWS ? P.in[I_XP] + ((size_t)g * GROWS + lr) * DM : P.in[I_XS] + (size_t)(lr - GROWS) * DM; }
__device__ __forceinline__ float* yrow(const Params& P, int g, int lr) { return lr < GROWS ? P.out + O_YP + ((size_t)g * GROWS + lr) * DM : P.out + O_YS + (size_t)(lr - GROWS) * DM; }
__device__ __forceinline__ int grows(int g) { return g == 0 ? GROWS : TMAX; }

enum { M_IN = 0, M_PA, M_PB, M_OUT, M_UP, M_DOWN, M_PG, M_PLE };
struct Epi {
    static constexpr bool PERM = true, AFTER_DRAIN = false;
    const float *xp, *xs, *gq, *gk, *bgate, *dtb; float* out; unsigned char* wsb; int mode; int g; const LAS float* ev; int rsb;
    __device__ __forceinline__ void operator()(const f32x4 (&acc)[2][2][4][2], const pg8::Unit& u, int wr, int wc, int fr_, int fq_) const {
        int fr = fr_, fq = fq_; asm volatile("" : "+v"(fr), "+v"(fq));
        const int lane_ = fr + 16 * fq;
        unsigned char* ws = wsb;
        const int r0 = wr * 64 + fr;
        const int cb = wc * 32 + fq * 8;
        const bool smp = (u.pm == 64);
        if (mode == M_IN) {
            const int pn = u.pn;
            if (pn < 8) {
                const bool isk = pn >= 4; const int head = 4 * (pn & 3) + wc;
                const LAS float* gw = ev + (isk ? 64 : 0);
                float gv[2][8];
#pragma unroll
                for (int bj = 0; bj < 2; ++bj)
#pragma unroll
                    for (int e = 0; e < 8; ++e) gv[bj][e] = gw[32 * bj + 8 * fq + e];
#pragma unroll
                for (int ai = 0; ai < 2; ++ai)
#pragma unroll
                    for (int m = 0; m < 4; ++m) {
                        const int r = ai * 128 + m * 16 + r0; const int lr = u.pm * 256 + r;
                        float ss = 0.f;
#pragma unroll
                        for (int bj = 0; bj < 2; ++bj)
#pragma unroll
                            for (int n = 0; n < 2; ++n) { const f32x4 x = acc[ai][bj][m][n]; ss += x[0] * x[0] + x[1] * x[1] + x[2] * x[2] + x[3] * x[3]; }
                        ss += __shfl_xor(ss, 16); ss += __shfl_xor(ss, 32);
                        const float rs = rsqrtf(ss * (1.f / 64.f) + EPS);
                        int b, t; if (smp) { b = r >> 5; t = r & 31; } else { b = g * 8 + (u.pm >> 3); t = (u.pm & 7) * 256 + r; }
#pragma unroll
                        for (int bj = 0; bj < 2; ++bj) {
                            float v[8];
#pragma unroll
                            for (int e = 0; e < 8; ++e) v[e] = acc[ai][bj][m][e >> 2][e & 3] * rs * gv[bj][e];
                            const int col = head * 64 + 32 * bj + 8 * fq;
                            if (!isk) {
#pragma unroll
                                for (int e = 0; e < 8; ++e) v[e] *= QSCALE;
                                *(u32x4*)((bf16_t*)(ws + WS_Q) + (size_t)lr * 1024 + col) = pack8(v);
                            } else {
                                const int tk = smp ? 512 + t : t;
                                bf16_t* dst = (smp ? (bf16_t*)(ws + WS_KS) + ((size_t)b * 16 + head) * 576 * 64 : (bf16_t*)(ws + WS_K) + ((size_t)(u.pm >> 3) * 16 + head) * 2048 * 64)
                                              + (size_t)(tk >> 4) * 1024 + bj * 512 + fq * 128 + (tk & 15) * 8;
                                *(u32x4*)dst = pack8(v);
                                float* o = nullptr;
                                if (smp) o = out + O_KS + ((size_t)b * 32 + t) * 1024 + col; else if (t >= 1536) o = out + O_KP + ((size_t)b * 512 + (t - 1536)) * 1024 + col;
                                if (o) { *(f32x4*)o = (f32x4){v[0], v[1], v[2], v[3]}; *(f32x4*)(o + 4) = (f32x4){v[4], v[5], v[6], v[7]}; }
                            }
                        }
                    }
            } else if (pn < 12) {
#pragma unroll
                for (int ai = 0; ai < 2; ++ai)
#pragma unroll
                    for (int m = 0; m < 4; ++m) {
                        const int r = ai * 128 + m * 16 + r0;
                        int b, t; if (smp) { b = r >> 5; t = r & 31; } else { b = g * 8 + (u.pm >> 3); t = (u.pm & 7) * 256 + r; }
#pragma unroll
                        for (int bj = 0; bj < 2; ++bj) {
                            const int ch = (pn - 8) * 256 + bj * 128 + cb;
                            const int tt_ = smp ? 512 + t : t, j = fr & 3;
                            float v[8];
#pragma unroll
                            for (int e = 0; e < 8; ++e) v[e] = acc[ai][bj][m][e >> 2][e & 3];
                            const unsigned p0 = pk2(v[0], v[1]), p1 = pk2(v[2], v[3]), p2 = pk2(v[4], v[5]), p3 = pk2(v[6], v[7]);
                            unsigned got[4];
#pragma unroll
                            for (int r = 0; r < 4; ++r) { const int si = (j - r) & 3; const unsigned send = si == 0 ? p0 : (si == 1 ? p1 : (si == 2 ? p2 : p3)); got[r] = (unsigned)__shfl((int)send, (lane_ & ~3) | ((j + r) & 3)); }
                            unsigned tk[4];
#pragma unroll
                            for (int k = 0; k < 4; ++k) { const int gi = (k - j) & 3; tk[k] = gi == 0 ? got[0] : (gi == 1 ? got[1] : (gi == 2 ? got[2] : got[3])); }
                            u32x4 w; w.x = (tk[0] & 0xffffu) | (tk[1] << 16); w.y = (tk[2] & 0xffffu) | (tk[3] << 16); w.z = (tk[0] >> 16) | (tk[1] & 0xffff0000u); w.w = (tk[2] >> 16) | (tk[3] & 0xffff0000u);
                            *(u32x4*)((smp ? (bf16_t*)(ws + WS_VTS) + (size_t)b * 576 * 1024 : (bf16_t*)(ws + WS_VT) + (size_t)(u.pm >> 3) * 2048 * 1024) + ((size_t)((tt_ - j) >> 2) * 1024 + ch + 2 * j) * 4) = w;
                            float* o = nullptr;
                            if (smp) o = out + O_VS + ((size_t)b * 32 + t) * 1024 + ch; else if (t >= 1536) o = out + O_VP + ((size_t)b * 512 + (t - 1536)) * 1024 + ch;
                            if (o) { *(f32x4*)o = (f32x4){v[0], v[1], v[2], v[3]}; *(f32x4*)(o + 4) = (f32x4){v[4], v[5], v[6], v[7]}; }
                        }
                    }
            } else if (pn < 40) {
                const int kind = pn < 20 ? 0 : (pn < 32 ? 1 : 2);
                const int ct0 = (kind == 0 ? (pn - 12) : kind == 1 ? (pn - 20) : (pn - 32)) * 256;
                const int ld = kind == 1 ? 3072 : 2048;
                bf16_t* base = (bf16_t*)(ws + (kind == 0 ? WS_Z : kind == 1 ? WS_XBC : WS_GT));
                float bv[2][8];
#pragma unroll
                for (int bj = 0; bj < 2; ++bj)
#pragma unroll
                    for (int e = 0; e < 8; ++e) bv[bj][e] = kind == 2 ? ev[256 + ct0 + bj * 128 + cb + e] : 0.f;
#pragma unroll
                for (int ai = 0; ai < 2; ++ai)
#pragma unroll
                    for (int m = 0; m < 4; ++m) {
                        const int r = ai * 128 + m * 16 + r0; const int lr = u.pm * 256 + r;
                        int b, t, len; if (smp) { b = r >> 5; t = r & 31; len = 32; } else { b = g * 8 + (u.pm >> 3); t = (u.pm & 7) * 256 + r; len = 2048; }
#pragma unroll
                        for (int bj = 0; bj < 2; ++bj) {
                            const int col = ct0 + bj * 128 + cb;
                            float v[8];
#pragma unroll
                            for (int e = 0; e < 8; ++e) { float x = acc[ai][bj][m][e >> 2][e & 3]; v[e] = kind == 2 ? sigmoidf_(x + bv[bj][e]) : x; }
                            *(u32x4*)(base + (size_t)lr * ld + col) = pack8(v);
                            if (kind == 1 && t >= len - 3) {
                                float* o = smp ? out + O_CSS + ((size_t)b * 3 + (t - 29)) * 3072 + col : out + O_CSP + ((size_t)b * 3 + (t - 2045)) * 3072 + col;
                                *(f32x4*)o = (f32x4){v[0], v[1], v[2], v[3]}; *(f32x4*)(o + 4) = (f32x4){v[4], v[5], v[6], v[7]};
                            }
                        }
                    }
            } else {
                if (wc == 0) {
                    float db[8];
#pragma unroll
                    for (int e = 0; e < 8; ++e) db[e] = ev[128 + 8 * fq + e];
#pragma unroll
                    for (int ai = 0; ai < 2; ++ai)
#pragma unroll
                        for (int m = 0; m < 4; ++m) {
                            const int lr = u.pm * 256 + ai * 128 + m * 16 + r0;
                            float v[8];
#pragma unroll
                            for (int e = 0; e < 8; ++e) { const float x = acc[ai][0][m][e >> 2][e & 3] + db[e]; v[e] = x > 20.f ? x : log1pf(__expf(x)); }
                            float* o = (float*)(ws + WS_DT) + (size_t)lr * 32 + 8 * fq;
                            *(f32x4*)o = (f32x4){v[0], v[1], v[2], v[3]}; *(f32x4*)(o + 4) = (f32x4){v[4], v[5], v[6], v[7]};
                        }
                }
            }
            return;
        }
#pragma unroll
        for (int ai = 0; ai < 2; ++ai)
#pragma unroll
            for (int m = 0; m < 4; ++m) {
                const int r = ai * 128 + m * 16 + r0; const int lr = u.pm * 256 + r;
                float rs = 1.f, rss = 0.f;
                const bool rs_lds = (mode == M_PB || mode == M_UP || mode == M_PG) && ((u.pm >> 3) << 3) == rsb;
                if (rs_lds) rs = ev[(u.pm & 7) * 256 + r];
                if (!rs_lds && (mode == M_UP || mode == M_PG)) { const f32x4* sp = (const f32x4*)((const float*)(ws + WS_SSX) + (size_t)lr * 16); float s = 0.f;
#pragma unroll
                    for (int q4 = 0; q4 < 4; ++q4) { const f32x4 x = sp[q4]; s += (x[0] + x[1]) + (x[2] + x[3]); }
                    rs = rsqrtf(s * (1.f / 1024.f) + EPS); }
                if (!rs_lds && mode == M_PB) { const f32x4* sp = (const f32x4*)((const float*)(ws + WS_SSQ) + (size_t)lr * 32); float s = 0.f;
#pragma unroll
                    for (int q4 = 0; q4 < 8; ++q4) { const f32x4 x = sp[q4]; s += (x[0] + x[1]) + (x[2] + x[3]); }
                    rs = rsqrtf(s * (1.f / 2048.f) + EPS); }
#pragma unroll
                for (int bj = 0; bj < 2; ++bj) {
                    const int col = u.pn * 256 + bj * 128 + cb;
                    float a[8];
#pragma unroll
                    for (int e = 0; e < 8; ++e) a[e] = acc[ai][bj][m][e >> 2][e & 3];
                    if (mode == M_PA || mode == M_PB) {
                        bf16_t* mp = (bf16_t*)(ws + WS_H) + (size_t)lr * 1024 + col;
                        float gt[8]; unpack8(*(const u32x4*)((const bf16_t*)(ws + WS_GT) + (size_t)lr * 2048 + (mode == M_PB ? 1024 : 0) + col), gt);
                        float v[8];
                        if (mode == M_PA) {
#pragma unroll
                            for (int e = 0; e < 8; ++e) v[e] = gt[e] * a[e];
                        } else {
                            float s[8]; unpack8(*(const u32x4*)mp, s);
#pragma unroll
                            for (int e = 0; e < 8; ++e) v[e] = s[e] + gt[e] * rs * a[e];
                        }
                        *(u32x4*)mp = pack8(v);
                    } else if (mode == M_OUT || mode == M_DOWN) {
                        bf16_t* xbp = (bf16_t*)(ws + WS_XB) + (size_t)lr * 1024 + col;
                        float v[8];
                        if (mode == M_OUT) {
                            const float* xr = (lr < GROWS ? xp + ((size_t)g * GROWS + lr) * DM : xs + (size_t)(lr - GROWS) * DM) + col;
                            const f32x4 x0 = *(const f32x4*)xr, x1 = *(const f32x4*)(xr + 4);
                            v[0] = x0[0]; v[1] = x0[1]; v[2] = x0[2]; v[3] = x0[3]; v[4] = x1[0]; v[5] = x1[1]; v[6] = x1[2]; v[7] = x1[3];
                        } else unpack8(*(const u32x4*)xbp, v);
#pragma unroll
                        for (int e = 0; e < 8; ++e) v[e] += a[e];
                        *(u32x4*)xbp = pack8(v);
#pragma unroll
                        for (int e = 0; e < 8; ++e) rss += v[e] * v[e];
                    } else if (mode == M_UP) {
#pragma unroll
                        for (int e = 0; e < 8; ++e) a[e] *= rs;
                        *(u32x4*)((bf16_t*)(ws + WS_U) + (size_t)lr * 6144 + col) = pack8(a);
                        int b, t, len; if (smp) { b = r >> 5; t = r & 31; len = 32; } else { b = g * 8 + (u.pm >> 3); t = (u.pm & 7) * 256 + r; len = 2048; }
                        if (t >= len - 2) {
                            float* o = smp ? out + O_CFS + ((size_t)b * 2 + (t - 30)) * 6144 + col : out + O_CFP + ((size_t)b * 2 + (t - 2046)) * 6144 + col;
                            *(f32x4*)o = (f32x4){a[0], a[1], a[2], a[3]}; *(f32x4*)(o + 4) = (f32x4){a[4], a[5], a[6], a[7]};
                        }
                    } else if (mode == M_PG) {
                        float v[8];
#pragma unroll
                        for (int e = 0; e < 8; ++e) v[e] = sigmoidf_(a[e] * rs);
                        *(u32x4*)((bf16_t*)(ws + WS_ST) + (size_t)lr * 1024 + col) = pack8(v);
                    } else {
                        float s[8]; unpack8(*(const u32x4*)((const bf16_t*)(ws + WS_ST) + (size_t)lr * 1024 + col), s);
                        float xv[8]; unpack8(*(const u32x4*)((const bf16_t*)(ws + WS_XB) + (size_t)lr * 1024 + col), xv);
                        float* yr = (lr < GROWS ? out + O_YP + ((size_t)g * GROWS + lr) * DM : out + O_YS + (size_t)(lr - GROWS) * DM) + col;
                        *(f32x4*)yr = (f32x4){xv[0] + s[0] * a[0], xv[1] + s[1] * a[1], xv[2] + s[2] * a[2], xv[3] + s[3] * a[3]};
                        *(f32x4*)(yr + 4) = (f32x4){xv[4] + s[4] * a[4], xv[5] + s[5] * a[5], xv[6] + s[6] * a[6], xv[7] + s[7] * a[7]};
                    }
                }
                if (mode == M_OUT || mode == M_DOWN) {
                    rss += __shfl_xor(rss, 16); rss += __shfl_xor(rss, 32);
                    if (fq == 0) ((float*)(ws + WS_SSX))[(size_t)lr * 16 + u.pn * 4 + wc] = rss;
                }
            }
    }
};

__device__ __forceinline__ void run_gemm(LAS unsigned char* lds, const Params& P, int mode, int g, const bf16_t* A, const bf16_t* Bt, int M, int N, int K, int wv) {
    pg8::Gemm gm{A, Bt, M, N, K}; pg8::StaticOrder S; S.init(M, N, (int)gridDim.x, lbid());
    if (mode == M_IN) {
        LAS float* ev = (LAS float*)(lds + 131072); const int t_ = ltid_w(wv);
        for (int i = t_; i < 2304; i += 512) ev[i] = i < 64 ? P.in[I_GQ][i] : (i < 128 ? P.in[I_GK][i - 64] : (i < 160 ? P.in[I_DTB][i - 128] : (i < 256 ? 0.f : P.in[I_BGATE][i - 256])));
        __syncthreads();
    }
    int rsb_ = -1;
    if (mode == M_PB || mode == M_UP || mode == M_PG) {
        pg8::Unit u0; const bool has_ = S.next(0, u0);
        if (has_) {
            rsb_ = (u0.pm >> 3) << 3;
            LAS float* rt = (LAS float*)(lds + 131072); const int t_ = ltid_w(wv); const unsigned char* ws_ = lws(P);
            for (int r = t_; r < 2048; r += 512) {
                const int lr = rsb_ * 256 + r; float s = 0.f;
                if (lr < M) {
                    if (mode == M_PB) { const f32x4* sp = (const f32x4*)((const float*)(ws_ + WS_SSQ) + (size_t)lr * 32);
#pragma unroll
                        for (int q4 = 0; q4 < 8; ++q4) { const f32x4 x = sp[q4]; s += (x[0] + x[1]) + (x[2] + x[3]); }
                        s = rsqrtf(s * (1.f / 2048.f) + EPS);
                    } else { const f32x4* sp = (const f32x4*)((const float*)(ws_ + WS_SSX) + (size_t)lr * 16);
#pragma unroll
                        for (int q4 = 0; q4 < 4; ++q4) { const f32x4 x = sp[q4]; s += (x[0] + x[1]) + (x[2] + x[3]); }
                        s = rsqrtf(s * (1.f / 1024.f) + EPS);
                    }
                }
                rt[r] = s;
            }
        }
        __syncthreads();
    }
    Epi E{P.in[I_XP], P.in[I_XS], P.in[I_GQ], P.in[I_GK], P.in[I_BGATE], P.in[I_DTB], P.out, lws(P), mode, g, (const LAS float*)(lds + 131072), rsb_};
    pg8::gemm_phase<Epi, pg8::StaticOrder, true, true>(lds, gm, S, E, ltid_w(wv));
    __syncthreads();
}

__device__ __forceinline__ void tr_item(const float* W, int ldsrc, int srccol0, int k0, bf16_t* WT, size_t dstrow0, int ldd, const float* kscale, LAS float* scr, int lane) {
#pragma unroll
    for (int i = 0; i < 8; ++i) { const int kk = 8 * i + (lane >> 3), c4 = (lane & 7) * 4; f32x4 v = (f32x4){0.f, 0.f, 0.f, 0.f};
        if (srccol0 >= 0) { v = *(const f32x4*)(W + (size_t)(k0 + kk) * ldsrc + srccol0 + c4); if (kscale) v = v * kscale[k0 + kk]; }
        scr[kk * 33 + c4] = v[0]; scr[kk * 33 + c4 + 1] = v[1]; scr[kk * 33 + c4 + 2] = v[2]; scr[kk * 33 + c4 + 3] = v[3]; }
    asm volatile("s_waitcnt lgkmcnt(0)" ::: "memory");
    const int c = lane & 7;
#pragma unroll
    for (int j = 0; j < 4; ++j) { const int n = (lane >> 3) + 8 * j; const LAS float* s = scr + (8 * c) * 33 + n;
        u32x4 o; o.x = pk2(s[0 * 33], s[1 * 33]); o.y = pk2(s[2 * 33], s[3 * 33]); o.z = pk2(s[4 * 33], s[5 * 33]); o.w = pk2(s[6 * 33], s[7 * 33]);
        *(u32x4*)(WT + (dstrow0 + n) * (size_t)ldd + k0 + 8 * c) = o; }
    asm volatile("s_waitcnt lgkmcnt(0)" ::: "memory");
}
__device__ __forceinline__ int win_srccol(int n0) {
    const int tile = n0 >> 8, tc = n0 & 255;
    if (tile < 8) { const int bj = tc >> 7, wc = (tc & 127) >> 5; return (tile < 4 ? 0 : 1024) + (4 * (tile & 3) + wc) * 64 + 32 * bj; }
    if (tile < 12) return 2048 + (tile - 8) * 256 + tc;
    if (tile < 20) return 3072 + (tile - 12) * 256 + tc;
    if (tile < 32) return 5120 + (tile - 20) * 256 + tc;
    if (tile < 40) return 8224 + (tile - 32) * 256 + tc;
    return tc < 32 ? 8192 + tc : -1;
}
__device__ __forceinline__ void tr_matrix(const float* W, int K, int ldsrc, int Ndst, bool winmap, bf16_t* WT, int ldd, const float* kscale, LAS float* scr, int gw, int NGW, int lane) {
    const int nblk = Ndst / 32, nit = (K / 64) * nblk;
    for (int it = gw; it < nit; it += NGW) { const int kb = it / nblk, nb = it % nblk; tr_item(W, ldsrc, winmap ? win_srccol(nb * 32) : nb * 32, kb * 64, WT, (size_t)nb * 32, ldd, kscale, scr, lane); }
}
__device__ __forceinline__ void prologue(const Params& P, LAS unsigned char* lds, int wv) {
    const int tid = ltid_w(wv), lane = tid & 63, wave = tid >> 6;
    LAS float* scr = (LAS float*)(lds + wave * 16384);
    const int gw = lbid() * 8 + wave, NGW = gridDim.x * 8;
    unsigned char* ws = lws(P);
    tr_matrix(P.in[I_WIN], 1024, NIN, NINP, true, (bf16_t*)(ws + WS_W1T), 1024, nullptr, scr, gw, NGW, lane);
    tr_matrix(P.in[I_WUP], 1024, 6144, 6144, false, (bf16_t*)(ws + WS_WUT), 1024, P.in[I_GFFN], scr, gw, NGW, lane);
    tr_matrix(P.in[I_WDOWN], 3072, 1024, 1024, false, (bf16_t*)(ws + WS_WDT), 3072, nullptr, scr, gw, NGW, lane);
    tr_matrix(P.in[I_WPB], 2048, 1024, 1024, false, (bf16_t*)(ws + WS_WBT), 2048, P.in[I_GSSM], scr, gw, NGW, lane);
    tr_matrix(P.in[I_WPA], 1024, 1024, 1024, false, (bf16_t*)(ws + WS_WAT), 1024, nullptr, scr, gw, NGW, lane);
    tr_matrix(P.in[I_WOUT], 1024, 1024, 1024, false, (bf16_t*)(ws + WS_WOT), 1024, nullptr, scr, gw, NGW, lane);
    tr_matrix(P.in[I_WPG], 1024, 1024, 1024, false, (bf16_t*)(ws + WS_WGT), 1024, P.in[I_GPLE], scr, gw, NGW, lane);
    tr_matrix(P.in[I_WPLE], 256, 1024, 1024, false, (bf16_t*)(ws + WS_WPT), 256, nullptr, scr, gw, NGW, lane);
    const size_t gt = (size_t)lbid() * 512 + tid, GT = (size_t)gridDim.x * 512;
    for (size_t i = gt; i < (size_t)8 * 512 * 128; i += GT) {
        const size_t b = i / (512 * 128), t = (i / 128) % 512, c8 = i % 128, head = c8 >> 3, d8 = c8 & 7;
        const f32x4 a = *(const f32x4*)(P.in[I_CK] + i * 8), c = *(const f32x4*)(P.in[I_CK] + i * 8 + 4);
        u32x4 w; w.x = pk2(a[0], a[1]); w.y = pk2(a[2], a[3]); w.z = pk2(c[0], c[1]); w.w = pk2(c[2], c[3]);
        *(u32x4*)((bf16_t*)(ws + WS_KS) + (b * 16 + head) * 576 * 64 + (t >> 4) * 1024 + (d8 >> 2) * 512 + (d8 & 3) * 128 + (t & 15) * 8) = w;
    }
    for (size_t i = gt; i < (size_t)8 * 16 * 256; i += GT) { const size_t bh = i / 256, rem = i % 256; *(u32x4*)((bf16_t*)(ws + WS_KS) + bh * 576 * 64 + (size_t)34 * 1024 + rem * 8) = (u32x4){0, 0, 0, 0}; }
    for (size_t i = gt; i < (size_t)8 * 128 * 128; i += GT) {
        const size_t b = i / (128 * 128), tg = (i / 128) % 128, c8 = i % 128;
        float v[4][8];
#pragma unroll
        for (int k = 0; k < 4; ++k) { const float* sp = P.in[I_CV] + ((b * 512 + tg * 4 + k) * 1024 + c8 * 8); const f32x4 a = *(const f32x4*)sp, c = *(const f32x4*)(sp + 4); v[k][0] = a[0]; v[k][1] = a[1]; v[k][2] = a[2]; v[k][3] = a[3]; v[k][4] = c[0]; v[k][5] = c[1]; v[k][6] = c[2]; v[k][7] = c[3]; }
        bf16_t* dp = (bf16_t*)(ws + WS_VTS) + b * 576 * 1024 + (tg * 1024 + c8 * 8) * 4;
#pragma unroll
        for (int e = 0; e < 8; e += 2) { u32x4 w; w.x = pk2(v[0][e], v[1][e]); w.y = pk2(v[2][e], v[3][e]); w.z = pk2(v[0][e + 1], v[1][e + 1]); w.w = pk2(v[2][e + 1], v[3][e + 1]); *(u32x4*)(dp + e * 4) = w; }
    }
    for (size_t i = gt; i < (size_t)8 * 8 * 512; i += GT) { const size_t b = i / (8 * 512), rem = i % (8 * 512); *(u32x4*)((bf16_t*)(ws + WS_VTS) + b * 576 * 1024 + (size_t)136 * 4096 + rem * 8) = (u32x4){0, 0, 0, 0}; }
}

__device__ __forceinline__ void norm_pass(const Params& P, int g, int wv) {
    const int tid = ltid_w(wv), lane = tid & 63, wave = tid >> 6;
    const int gw = lbid() * 8 + wave, NGW = gridDim.x * 8, nr = grows(g);
    const float* gvec = P.in[I_GMIX];
    f32x4 gv[4];
#pragma unroll
    for (int j = 0; j < 4; ++j) gv[j] = *(const f32x4*)(gvec + 4 * lane + 256 * j);
    unsigned char* ws = lws(P);
    bf16_t* dst = (bf16_t*)(ws + (g == 0 ? WS_H : WS_H1)); bf16_t* ped = (bf16_t*)(ws + (g == 0 ? WS_PE : WS_PE1));
    for (int lr = gw; lr < nr; lr += NGW) {
        const float* src = xrow(P, g, lr);
        f32x4 v[4]; float s = 0.f;
#pragma unroll
        for (int j = 0; j < 4; ++j) { v[j] = *(const f32x4*)(src + 4 * lane + 256 * j); s += v[j][0] * v[j][0] + v[j][1] * v[j][1] + v[j][2] * v[j][2] + v[j][3] * v[j][3]; }
        const float rs = rsqrtf(wave_sum(s) * (1.f / 1024.f) + EPS);
#pragma unroll
        for (int j = 0; j < 4; ++j) { u32x2 w; w.x = pk2(v[j][0] * rs * gv[j][0], v[j][1] * rs * gv[j][1]); w.y = pk2(v[j][2] * rs * gv[j][2], v[j][3] * rs * gv[j][3]); *(u32x2*)(dst + (size_t)lr * 1024 + 4 * lane + 256 * j) = w; }
        const float* pr = lr < GROWS ? P.in[I_PP] + ((size_t)g * GROWS + lr) * PLE : P.in[I_PS] + (size_t)(lr - GROWS) * PLE;
        const f32x4 pv = *(const f32x4*)(pr + 4 * lane); u32x2 w; w.x = pk2(pv[0], pv[1]); w.y = pk2(pv[2], pv[3]);
        *(u32x2*)(ped + (size_t)lr * PLE + 4 * lane) = w;
    }
}

__device__ __forceinline__ bf16_t* bcc_row(const Params& P, int g, int lr) {
    return lr < GROWS ? (bf16_t*)(P.out + O_YP + (size_t)g * GROWS * DM) + (size_t)lr * 1024 : (bf16_t*)(P.out + O_YS) + (size_t)(lr - GROWS) * 1024;
}
__device__ __forceinline__ void bc_prepass(const Params& P, int g, int wv) {
    const size_t gt = (size_t)lbid() * 512 + ltid_w(wv), GT = (size_t)gridDim.x * 512;
    unsigned char* ws = lws(P);
    const bf16_t* xbc = (const bf16_t*)(ws + WS_XBC);
    const size_t n = (size_t)(grows(g) / 8) * 128;
    for (size_t i = gt; i < n; i += GT) {
        const int rg = (int)(i / 128), c0 = (int)(i % 128) * 8, lr0 = rg * 8, ch = 2048 + c0;
        int t0, sb = 0; const bool smp = lr0 >= GROWS; if (smp) { sb = (lr0 - GROWS) >> 5; t0 = (lr0 - GROWS) & 31; } else t0 = lr0 & 2047;
        float w[5][8];
#pragma unroll
        for (int k = 0; k < 5; ++k) { const float* wp = (k < 4 ? P.in[I_CSW] + k * 3072 : P.in[I_CSB]) + ch; const f32x4 a = *(const f32x4*)wp, b2 = *(const f32x4*)(wp + 4);
            w[k][0] = a[0]; w[k][1] = a[1]; w[k][2] = a[2]; w[k][3] = a[3]; w[k][4] = b2[0]; w[k][5] = b2[1]; w[k][6] = b2[2]; w[k][7] = b2[3]; }
        float pa[8], pb[8], pc[8];
#pragma unroll
        for (int k = 0; k < 3; ++k) {
            float* dst = k == 0 ? pa : (k == 1 ? pb : pc);
            if (t0 > 0) unpack8(*(const u32x4*)(xbc + (size_t)(lr0 - 3 + k) * 3072 + ch), dst);
            else if (smp) { const float* cp = P.in[I_CSSM] + ((size_t)sb * 3 + k) * 3072 + ch; const f32x4 a = *(const f32x4*)cp, b2 = *(const f32x4*)(cp + 4); dst[0] = a[0]; dst[1] = a[1]; dst[2] = a[2]; dst[3] = a[3]; dst[4] = b2[0]; dst[5] = b2[1]; dst[6] = b2[2]; dst[7] = b2[3]; }
            else {
#pragma unroll
                for (int e = 0; e < 8; ++e) dst[e] = 0.f;
            }
        }
#pragma unroll
        for (int r = 0; r < 8; ++r) {
            float cur[8], o[8];
            unpack8(*(const u32x4*)(xbc + (size_t)(lr0 + r) * 3072 + ch), cur);
#pragma unroll
            for (int e = 0; e < 8; ++e) { o[e] = siluf_(w[4][e] + w[0][e] * pa[e] + w[1][e] * pb[e] + w[2][e] * pc[e] + w[3][e] * cur[e]); pa[e] = pb[e]; pb[e] = pc[e]; pc[e] = cur[e]; }
            *(u32x4*)(bcc_row(P, g, lr0 + r) + c0) = pack8(o);
        }
    }
}

#define MFMA16(a, b, c) __builtin_amdgcn_mfma_f32_16x16x32_bf16((a), (b), (c), 0, 0, 0)
#define VMWAIT0() asm volatile("s_waitcnt vmcnt(0)" ::: "memory")
constexpr int SSD_RAW = 108800, SSD_ZS = 148608;
__device__ __forceinline__ int ssd_chmap(int c0, int h, int grp) { return c0 < 64 ? h * 64 + c0 : (c0 < 192 ? 2048 + grp * 128 + (c0 - 64) : 2560 + grp * 128 + (c0 - 192)); }
__device__ __forceinline__ void ssd_item(const Params& P, LAS unsigned char* lds, int g, int item, int wv) {
    const int tid = ltid_w(wv), lane = tid & 63, wave = __builtin_amdgcn_readfirstlane(tid >> 6), fr = lane & 15, fq = lane >> 4;
    unsigned char* ws = lws(P);
    const bool smp = item >= 256;
    const int sq = smp ? (item - 256) >> 5 : item >> 5, h = item & 31, grp = h >> 3;
    const int lr0 = smp ? GROWS + sq * 32 : sq * 2048, L = smp ? 32 : 64, nch = smp ? 1 : 32;
    LAS bf16_t* Xt = (LAS bf16_t*)(lds);
    LAS bf16_t* Xwt = (LAS bf16_t*)(lds + 10240);
    LAS bf16_t* Bm = (LAS bf16_t*)(lds + 20480);
    LAS bf16_t* Bt = (LAS bf16_t*)(lds + 38912);
    LAS bf16_t* Cm = (LAS bf16_t*)(lds + 59392);
    LAS bf16_t* Gm = (LAS bf16_t*)(lds + 77824);
    LAS bf16_t* Hb = (LAS bf16_t*)(lds + 88064);
    LAS float* sacs = (LAS float*)(lds + 107776);
    LAS float* sdt = sacs + 64;
    LAS float* sred = sacs + 128;
    LAS unsigned char* rawb = lds + SSD_RAW;
    LAS bf16_t* Zs = (LAS bf16_t*)(lds + SSD_ZS);
    const float aneg = -__expf(P.in[I_ALOG][h]), dskip = P.in[I_DSKIP][h];
    const bf16_t* xbc = (const bf16_t*)(ws + WS_XBC);
    const float* dtp = (const float*)(ws + WS_DT);
    bf16_t* zb = (bf16_t*)(ws + WS_Z);
    float* ssq = (float*)(ws + WS_SSQ);
    LAS float* cw = (LAS float*)(lds + 106496);
    for (int i = tid; i < 5 * 64; i += 512) { const int k = i >> 6, cc = i & 63; cw[i] = k < 4 ? P.in[I_CSW][k * 3072 + h * 64 + cc] : P.in[I_CSB][h * 64 + cc]; }
    const bf16_t* bcc0 = bcc_row(P, g, 0);
    const int pbH = wave >> 1, nbH0 = 4 * (wave & 1);
    f32x4 Hacc[4];
#pragma unroll
    for (int tt = 0; tt < 4; ++tt) {
        Hacc[tt] = (f32x4){0.f, 0.f, 0.f, 0.f};
        if (smp) Hacc[tt] = *(const f32x4*)(P.in[I_SSM] + (((size_t)sq * 32 + h) * 64 + pbH * 16 + fr) * 128 + (nbH0 + tt) * 16 + 4 * fq);
        u32x2 w; w.x = pk2(Hacc[tt][0], Hacc[tt][1]); w.y = pk2(Hacc[tt][2], Hacc[tt][3]);
        *(LAS u32x2*)(Hb + (pbH * 16 + fr) * 144 + (nbH0 + tt) * 16 + 4 * fq) = w;
    }
#define SSD_RAW_DMA(cc) do { const int tokc0_ = lr0 + (cc) * L; _Pragma("unroll") for (int k_ = 0; k_ < 6; ++k_) { const int sb_ = (k_ * 8 + wave) * 64; if (sb_ < 2747) { const int s_ = sb_ + lane, row_ = s_ / 41, o_ = s_ - row_ * 41; \
        const bool ok_ = (s_ < 2747) && (o_ < 40) && ((cc) > 0 || row_ >= 3) && (row_ - 3 < L) && (o_ < 8 || row_ >= 3); \
        const int lrr_ = tokc0_ - 3 + row_; \
        const bf16_t* src_ = o_ < 8 ? xbc + (size_t)lrr_ * 3072 + h * 64 + o_ * 8 : (smp ? bcc_s : bcc0) + (size_t)(smp ? lrr_ - GROWS : lrr_) * 1024 + (o_ < 24 ? grp * 128 + (o_ - 8) * 8 : 512 + grp * 128 + (o_ - 24) * 8); \
        if (ok_) __builtin_amdgcn_global_load_lds((const unsigned*)src_, (LAS unsigned*)(rawb + sb_ * 16), 16, 0, 0); } } } while (0)
    const bf16_t* bcc_s = bcc_row(P, g, GROWS);
    SSD_RAW_DMA(0);
    if (tid < 120) {
        const int row = tid / 40, o = tid - row * 40; u32x4 w = (u32x4){0u, 0u, 0u, 0u};
        if (smp && o < 8) { const float* cp = P.in[I_CSSM] + ((size_t)sq * 3 + row) * 3072 + h * 64 + o * 8; const f32x4 a = *(const f32x4*)cp, b2 = *(const f32x4*)(cp + 4); float v[8] = {a[0], a[1], a[2], a[3], b2[0], b2[1], b2[2], b2[3]}; w = pack8(v); }
        *(LAS u32x4*)(rawb + (row * 41 + o) * 16) = w;
    }
    float dtn = lane < L ? dtp[(size_t)(lr0 + lane) * 32 + h] : 0.f;
    VMWAIT0(); __syncthreads();
    for (int c = 0; c < nch; ++c) {
        const int tok0 = lr0 + c * L;
        u32x2 zreg[2];
        { const int i_ = (wave >> 1) * 16 + fr;
#pragma unroll
          for (int tt = 0; tt < 2; ++tt) { zreg[tt] = (u32x2){0u, 0u}; if (i_ < L) zreg[tt] = *(const u32x2*)(zb + (size_t)(tok0 + i_) * 2048 + h * 64 + (2 * (wave & 1) + tt) * 16 + 4 * fq); } }
        const float dtl = dtn;
        if (c + 1 < nch) dtn = dtp[(size_t)(tok0 + L + lane) * 32 + h];
        float acs = dtl * aneg;
#pragma unroll
        for (int o = 1; o < 64; o <<= 1) { const float t = __shfl_up(acs, o); if (lane >= o) acs += t; }
        const float last = __shfl(acs, 63);
        if (wave == 0) { sacs[lane] = acs; sdt[lane] = dtl; if (c > 0 && lane < L) ssq[(size_t)(tok0 - L + lane) * 32 + h] = sred[lane] + sred[64 + lane]; }
        {
            const int j = lane, xo = wave, c0 = xo * 8;
            float v[8];
#pragma unroll
            for (int e = 0; e < 8; ++e) v[e] = cw[256 + c0 + e];
#pragma unroll
            for (int i = 0; i < 4; ++i) { float r[8]; unpack8(*(const LAS u32x4*)(rawb + ((j + i) * 41 + xo) * 16), r);
#pragma unroll
                for (int e = 0; e < 8; ++e) v[e] += cw[i * 64 + c0 + e] * r[e]; }
            const float wj = __expf(last - acs) * dtl;
#pragma unroll
            for (int e = 0; e < 8; ++e) { const float x = j < L ? siluf_(v[e]) : 0.f; Xt[(c0 + e) * 80 + j] = (bf16_t)(pk2(x, 0.f) & 0xffffu); Xwt[(c0 + e) * 80 + j] = (bf16_t)(pk2(x * wj, 0.f) & 0xffffu); }
#pragma unroll
            for (int k = 0; k < 4; ++k) {
                const int jj = lane, o2 = wave + 8 * k;
                u32x4 w = (u32x4){0u, 0u, 0u, 0u};
                if (jj < L) w = *(const LAS u32x4*)(rawb + ((jj + 3) * 41 + 8 + o2) * 16);
                if (o2 < 16) {
                    *(LAS u32x4*)(Bm + jj * 144 + o2 * 8) = w;
                    LAS bf16_t* bt = Bt + (o2 * 8) * 80 + jj;
                    bt[0 * 80] = (bf16_t)(w.x & 0xffffu); bt[1 * 80] = (bf16_t)(w.x >> 16); bt[2 * 80] = (bf16_t)(w.y & 0xffffu); bt[3 * 80] = (bf16_t)(w.y >> 16);
                    bt[4 * 80] = (bf16_t)(w.z & 0xffffu); bt[5 * 80] = (bf16_t)(w.z >> 16); bt[6 * 80] = (bf16_t)(w.w & 0xffffu); bt[7 * 80] = (bf16_t)(w.w >> 16);
                } else {
                    *(LAS u32x4*)(Cm + jj * 144 + (o2 - 16) * 8) = w;
                }
            }
        }
        asm volatile("s_waitcnt lgkmcnt(0)" ::: "memory"); __builtin_amdgcn_s_barrier(); asm volatile("" ::: "memory");
        if (c + 1 < nch) SSD_RAW_DMA(c + 1);
        const int ib = wave >> 1;
        const float acsi = sacs[ib * 16 + fr];
        f32x4 yin[2];
#pragma unroll
        for (int tt = 0; tt < 2; ++tt) {
            const int jb = 2 * (wave & 1) + tt;
            f32x4 cbv = (f32x4){0.f, 0.f, 0.f, 0.f};
            if (jb <= ib) {
#pragma unroll
                for (int ks = 0; ks < 4; ++ks) {
                    const bf16x8 a = *(const LAS bf16x8*)(Bm + (jb * 16 + fr) * 144 + ks * 32 + fq * 8);
                    const bf16x8 b2 = *(const LAS bf16x8*)(Cm + (ib * 16 + fr) * 144 + ks * 32 + fq * 8);
                    cbv = MFMA16(a, b2, cbv);
                }
                const int i = ib * 16 + fr;
#pragma unroll
                for (int e = 0; e < 4; ++e) { const int j = jb * 16 + 4 * fq + e; cbv[e] = (j <= i) ? cbv[e] * __expf(acsi - sacs[j]) * sdt[j] : 0.f; }
            }
            u32x2 w; w.x = pk2(cbv[0], cbv[1]); w.y = pk2(cbv[2], cbv[3]);
            *(LAS u32x2*)(Gm + (ib * 16 + fr) * 80 + jb * 16 + 4 * fq) = w;
            const int pb = jb;
            f32x4 y = (f32x4){0.f, 0.f, 0.f, 0.f};
#pragma unroll
            for (int ks = 0; ks < 4; ++ks) {
                const bf16x8 a = *(const LAS bf16x8*)(Hb + (pb * 16 + fr) * 144 + ks * 32 + fq * 8);
                const bf16x8 b2 = *(const LAS bf16x8*)(Cm + (ib * 16 + fr) * 144 + ks * 32 + fq * 8);
                y = MFMA16(a, b2, y);
            }
            yin[tt] = y;
        }
        asm volatile("s_waitcnt lgkmcnt(0)" ::: "memory"); __builtin_amdgcn_s_barrier(); asm volatile("" ::: "memory");
        {
            const int i = ib * 16 + fr; const float eai = __expf(acsi); float ss = 0.f;
#pragma unroll
            for (int tt = 0; tt < 2; ++tt) {
                const int pb = 2 * (wave & 1) + tt;
                f32x4 y = (f32x4){0.f, 0.f, 0.f, 0.f};
#pragma unroll
                for (int ks = 0; ks < 2; ++ks) {
                    const bf16x8 a = *(const LAS bf16x8*)(Xt + (pb * 16 + fr) * 80 + ks * 32 + fq * 8);
                    const bf16x8 b2 = *(const LAS bf16x8*)(Gm + (ib * 16 + fr) * 80 + ks * 32 + fq * 8);
                    y = MFMA16(a, b2, y);
                }
                if (i < L) {
                    const u32x2 zw = zreg[tt];
                    const float sz[4] = {siluf_(bflo(zw.x)), siluf_(bfhi(zw.x)), siluf_(bflo(zw.y)), siluf_(bfhi(zw.y))};
                    float o[4];
#pragma unroll
                    for (int e = 0; e < 4; ++e) { const float xs = bf2f(Xt[(pb * 16 + 4 * fq + e) * 80 + i]); o[e] = (y[e] + eai * yin[tt][e] + dskip * xs) * sz[e]; ss += o[e] * o[e]; }
                    u32x2 w; w.x = pk2(o[0], o[1]); w.y = pk2(o[2], o[3]);
                    *(u32x2*)(zb + (size_t)(tok0 + i) * 2048 + h * 64 + pb * 16 + 4 * fq) = w;
                }
            }
            ss += __shfl_xor(ss, 16); ss += __shfl_xor(ss, 32);
            if (fq == 0) sred[(wave & 1) * 64 + i] = ss;
        }
        {
            const float el = __expf(last);
#pragma unroll
            for (int tt = 0; tt < 4; ++tt) {
                Hacc[tt] = Hacc[tt] * el;
#pragma unroll
                for (int ks = 0; ks < 2; ++ks) {
                    const bf16x8 a = *(const LAS bf16x8*)(Bt + ((nbH0 + tt) * 16 + fr) * 80 + ks * 32 + fq * 8);
                    const bf16x8 b2 = *(const LAS bf16x8*)(Xwt + (pbH * 16 + fr) * 80 + ks * 32 + fq * 8);
                    Hacc[tt] = MFMA16(a, b2, Hacc[tt]);
                }
            }
        }
#pragma unroll
        for (int tt = 0; tt < 4; ++tt) { u32x2 w; w.x = pk2(Hacc[tt][0], Hacc[tt][1]); w.y = pk2(Hacc[tt][2], Hacc[tt][3]); *(LAS u32x2*)(Hb + (pbH * 16 + fr) * 144 + (nbH0 + tt) * 16 + 4 * fq) = w; }
        if (smp) { asm volatile("s_waitcnt vmcnt(0) lgkmcnt(0)" ::: "memory"); } else { asm volatile("s_waitcnt vmcnt(2) lgkmcnt(0)" ::: "memory"); }
        __builtin_amdgcn_s_barrier(); asm volatile("" ::: "memory");
    }
    VMWAIT0(); __syncthreads();
    if (wave == 0 && lane < L) ssq[(size_t)(lr0 + (nch - 1) * L + lane) * 32 + h] = sred[lane] + sred[64 + lane];
    float* so = smp ? P.out + O_SSMS + (((size_t)sq * 32 + h) * 64) * 128 : P.out + O_SSMP + ((((size_t)g * 8 + sq) * 32 + h) * 64) * 128;
#pragma unroll
    for (int tt = 0; tt < 4; ++tt) *(f32x4*)(so + (size_t)(pbH * 16 + fr) * 128 + (nbH0 + tt) * 16 + 4 * fq) = Hacc[tt];
}

__device__ __forceinline__ void attn_wave(bf16_t* qo, const bf16_t* Kh, const bf16_t* Vth, int VP, int qpos0, int kstart, int seq_len, int t_lo, const LAS float* tbl, int lane) {
    const int fr = lane & 15, fq = lane >> 4;
    bf16x8 qf[2][2];
#pragma unroll
    for (int qb = 0; qb < 2; ++qb)
#pragma unroll
        for (int ks = 0; ks < 2; ++ks) qf[qb][ks] = *(const bf16x8*)(qo + (size_t)(qb * 16 + fr) * 1024 + ks * 32 + fq * 8);
    f32x4 o[2][4];
#pragma unroll
    for (int qb = 0; qb < 2; ++qb)
#pragma unroll
        for (int d = 0; d < 4; ++d) o[qb][d] = (f32x4){0.f, 0.f, 0.f, 0.f};
    float mrun[2] = {-1e30f, -1e30f}, lsum[2] = {0.f, 0.f};
    bf16x8 kc[4][2];
    {
        const int kt0 = kstart + 64 * t_lo;
#pragma unroll
        for (int blk = 0; blk < 4; ++blk) { const bf16_t* kp = Kh + (size_t)((kt0 >> 4) + blk) * 1024 + fq * 128 + fr * 8; kc[blk][0] = *(const bf16x8*)kp; kc[blk][1] = *(const bf16x8*)(kp + 512); }
    }
    const float bc = tbl[256];
    s16x4 vlo[4][2], vhi[4][2];
    {
        const int kt0 = kstart + 64 * t_lo;
#pragma unroll
        for (int d = 0; d < 4; ++d)
#pragma unroll
            for (int ks = 0; ks < 2; ++ks) { const bf16_t* vp = Vth + ((size_t)((kt0 + 32 * ks + 4 * fq) >> 2) * 1024 + d * 16 + fr) * 4; vlo[d][ks] = *(const s16x4*)vp; vhi[d][ks] = *(const s16x4*)(vp + 4 * 1024 * 4); }
    }
    for (int t = t_lo; t < 9; ++t) {
        const int kt0 = kstart + 64 * t, kt1 = kstart + 64 * (t < 8 ? t + 1 : t);
        s16x4 vnl[4][2], vnh[4][2];
#pragma unroll
        for (int d = 0; d < 4; ++d)
#pragma unroll
            for (int ks = 0; ks < 2; ++ks) { const bf16_t* vp = Vth + ((size_t)((kt1 + 32 * ks + 4 * fq) >> 2) * 1024 + d * 16 + fr) * 4; vnl[d][ks] = *(const s16x4*)vp; vnh[d][ks] = *(const s16x4*)(vp + 4 * 1024 * 4); }
        bf16x8 kn[4][2];
#pragma unroll
        for (int blk = 0; blk < 4; ++blk) { const bf16_t* kp = Kh + (size_t)((kt1 >> 4) + blk) * 1024 + fq * 128 + fr * 8; kn[blk][0] = *(const bf16x8*)kp; kn[blk][1] = *(const bf16x8*)(kp + 512); }
        f32x4 s[2][4];
#pragma unroll
        for (int qb = 0; qb < 2; ++qb)
#pragma unroll
            for (int blk = 0; blk < 4; ++blk) { f32x4 z = (f32x4){0.f, 0.f, 0.f, 0.f}; z = MFMA16(kc[blk][0], qf[qb][0], z); s[qb][blk] = MFMA16(kc[blk][1], qf[qb][1], z); }
        const bool cst = (qpos0 - (kt0 + 63)) >= 128;
        const bool tail = (kt0 + 64) > seq_len;
        bf16x8 pbv[2][2];
#pragma unroll
        for (int qb = 0; qb < 2; ++qb) {
            const int qpos = qpos0 + qb * 16 + fr;
            float mx = -1e30f, cc;
            if (cst && !tail) {
#pragma unroll
                for (int blk = 0; blk < 4; ++blk) mx = fmaxf(fmaxf(mx, fmaxf(s[qb][blk][0], s[qb][blk][1])), fmaxf(s[qb][blk][2], s[qb][blk][3]));
                mx += bc; cc = bc;
            } else {
#pragma unroll
                for (int blk = 0; blk < 4; ++blk)
#pragma unroll
                    for (int e = 0; e < 4; ++e) {
                        const int kpos = kt0 + blk * 16 + 4 * fq + e;
                        int rel = qpos - kpos; rel = rel < -128 ? -128 : (rel > 128 ? 128 : rel);
                        float v = s[qb][blk][e] + tbl[rel + 128];
                        if (tail && kpos >= seq_len) v = -1e30f;
                        s[qb][blk][e] = v; mx = fmaxf(mx, v);
                    }
                cc = 0.f;
            }
            mx = fmaxf(mx, __shfl_xor(mx, 16)); mx = fmaxf(mx, __shfl_xor(mx, 32));
            const float mnew = fmaxf(mrun[qb], mx), sc = __builtin_amdgcn_exp2f(mrun[qb] - mnew);
            mrun[qb] = mnew; cc -= mnew;
            float ps = 0.f;
#pragma unroll
            for (int blk = 0; blk < 4; ++blk)
#pragma unroll
                for (int e = 0; e < 4; ++e) { const float p = __builtin_amdgcn_exp2f(s[qb][blk][e] + cc); s[qb][blk][e] = p; ps += p; }
            lsum[qb] = lsum[qb] * sc + ps;
            if (__any(sc != 1.f)) {
#pragma unroll
                for (int d = 0; d < 4; ++d) o[qb][d] = o[qb][d] * sc;
            }
#pragma unroll
            for (int ks = 0; ks < 2; ++ks) {
                u32x4 pw; pw.x = pk2(s[qb][2 * ks][0], s[qb][2 * ks][1]); pw.y = pk2(s[qb][2 * ks][2], s[qb][2 * ks][3]); pw.z = pk2(s[qb][2 * ks + 1][0], s[qb][2 * ks + 1][1]); pw.w = pk2(s[qb][2 * ks + 1][2], s[qb][2 * ks + 1][3]);
                pbv[qb][ks] = __builtin_bit_cast(bf16x8, pw);
            }
        }
#pragma unroll
        for (int ks = 0; ks < 2; ++ks)
#pragma unroll
            for (int d = 0; d < 4; ++d) {
                const bf16x8 a = (bf16x8){vlo[d][ks][0], vlo[d][ks][1], vlo[d][ks][2], vlo[d][ks][3], vhi[d][ks][0], vhi[d][ks][1], vhi[d][ks][2], vhi[d][ks][3]};
                o[0][d] = MFMA16(a, pbv[0][ks], o[0][d]); o[1][d] = MFMA16(a, pbv[1][ks], o[1][d]);
            }
#pragma unroll
        for (int blk = 0; blk < 4; ++blk) { kc[blk][0] = kn[blk][0]; kc[blk][1] = kn[blk][1]; }
#pragma unroll
        for (int d = 0; d < 4; ++d)
#pragma unroll
            for (int ks = 0; ks < 2; ++ks) { vlo[d][ks] = vnl[d][ks]; vhi[d][ks] = vnh[d][ks]; }
    }
#pragma unroll
    for (int qb = 0; qb < 2; ++qb) {
        float l = lsum[qb]; l += __shfl_xor(l, 16); l += __shfl_xor(l, 32);
        const float inv = 1.f / l;
#pragma unroll
        for (int d = 0; d < 4; ++d) { u32x2 w; w.x = pk2(o[qb][d][0] * inv, o[qb][d][1] * inv); w.y = pk2(o[qb][d][2] * inv, o[qb][d][3] * inv); *(u32x2*)(qo + (size_t)(qb * 16 + fr) * 1024 + d * 16 + 4 * fq) = w; }
    }
}

__device__ __forceinline__ void mixer_phase(const Params& P, LAS unsigned char* lds, int g, int wv) {
    const int tid = ltid_w(wv), lane = tid & 63, wave = __builtin_amdgcn_readfirstlane(tid >> 6);
    unsigned char* ws = lws(P);
    const int nssd = g == 0 ? 256 : 512;
    for (int it = lbid(); it < nssd; it += gridDim.x) { ssd_item(P, lds, g, it, wv); __syncthreads(); }
    LAS float* tbl = (LAS float*)lds;
    for (int i = tid; i < 16 * 257; i += 512) tbl[i] = P.in[I_REL][i] * LOG2E;
    __syncthreads();
    bf16_t* q = (bf16_t*)(ws + WS_Q);
    const int nblk = 8 * 32 * 4 + (g == 1 ? 16 : 0);
    for (int bu = lbid(); bu < nblk; bu += gridDim.x) {
        if (bu < 1024) {
            const int bl = bu >> 7, c = (bu >> 2) & 31, h = (bu & 3) * 4 + (wave >> 1), half = wave & 1;
            const int qpos0 = c * 64 + half * 32;
            attn_wave(q + ((size_t)bl * 2048 + qpos0) * 1024 + h * 64, (const bf16_t*)(ws + WS_K) + ((size_t)bl * 16 + h) * 2048 * 64,
                      (const bf16_t*)(ws + WS_VT) + (size_t)bl * 2048 * 1024 + h * 64 * 4, 2048, qpos0, c * 64 - 512, 2048, c < 8 ? 8 - c : 0, tbl + h * 257, lane);
        } else {
            const int wi = (bu - 1024) * 8 + wave, sb = wi >> 4, h = wi & 15;
            attn_wave(q + ((size_t)GROWS + sb * 32) * 1024 + h * 64, (const bf16_t*)(ws + WS_KS) + ((size_t)sb * 16 + h) * 576 * 64,
                      (const bf16_t*)(ws + WS_VTS) + (size_t)sb * 576 * 1024 + h * 64 * 4, 576, 512, 0, 544, 0, tbl + h * 257, lane);
        }
    }
}

__device__ __forceinline__ void sg_kloop(f32x4 (&acc)[4], const bf16_t* A, const bf16_t* Bt, int K, int row0, int col0, int wave, int fr, int fq) {
    const int ksub = K >> 3, k0 = wave * ksub;
    const bf16_t* ap = A + (size_t)(row0 + fr) * K + k0 + fq * 8;
    const bf16_t* bp = Bt + (size_t)(col0 + fr) * K + k0 + fq * 8;
    if (ksub >= 128) {
        for (int kk = 0; kk < ksub; kk += 128) {
            bf16x8 a[4], bq[4][4];
#pragma unroll
            for (int s = 0; s < 4; ++s) { a[s] = *(const bf16x8*)(ap + kk + 32 * s);
#pragma unroll
                for (int t = 0; t < 4; ++t) bq[s][t] = *(const bf16x8*)(bp + (size_t)(16 * t) * K + kk + 32 * s); }
#pragma unroll
            for (int s = 0; s < 4; ++s)
#pragma unroll
                for (int t = 0; t < 4; ++t) acc[t] = MFMA16(bq[s][t], a[s], acc[t]);
        }
    } else {
        for (int kk = 0; kk < ksub; kk += 32) {
            const bf16x8 a = *(const bf16x8*)(ap + kk);
#pragma unroll
            for (int t = 0; t < 4; ++t) { const bf16x8 bq = *(const bf16x8*)(bp + (size_t)(16 * t) * K + kk); acc[t] = MFMA16(bq, a, acc[t]); }
        }
    }
}
__device__ __forceinline__ void sg_reduce(f32x4 (&acc)[4], LAS float* red, int wave, int lane) {
    if (wave > 0) {
#pragma unroll
        for (int t = 0; t < 4; ++t)
#pragma unroll
            for (int e = 0; e < 4; ++e) red[((wave - 1) * 16 + t * 4 + e) * 64 + lane] = acc[t][e];
    }
    __syncthreads();
    if (wave == 0) {
#pragma unroll
        for (int w = 0; w < 7; ++w)
#pragma unroll
            for (int t = 0; t < 4; ++t)
#pragma unroll
                for (int e = 0; e < 4; ++e) acc[t][e] += red[(w * 16 + t * 4 + e) * 64 + lane];
    }
    __syncthreads();
}
enum { SM_AB = 0, SM_OUT, SM_UP, SM_DOWN, SM_PLE };
__device__ __forceinline__ void sample_stage(const Params& P, LAS unsigned char* lds, int mode, int wv) {
    const int tid = ltid_w(wv), lane = tid & 63, wave = __builtin_amdgcn_readfirstlane(tid >> 6), fr = lane & 15, fq = lane >> 4;
    unsigned char* ws = lws(P);
    LAS float* red = (LAS float*)lds;
    const int ncb = mode == SM_UP ? 96 : 16, ntask = 16 * ncb;
    for (int task = lbid(); task < ntask; task += gridDim.x) {
        const int rb = task / ncb, cb = task - rb * ncb, row0 = rb * 16, col0 = cb * 64;
        f32x4 acc[4], acc2[4];
#pragma unroll
        for (int t = 0; t < 4; ++t) { acc[t] = (f32x4){0.f, 0.f, 0.f, 0.f}; acc2[t] = (f32x4){0.f, 0.f, 0.f, 0.f}; }
        if (mode == SM_AB) {
            sg_kloop(acc, (const bf16_t*)(ws + WS_Q) + (size_t)GROWS * 1024, (const bf16_t*)(ws + WS_WAT), 1024, row0, col0, wave, fr, fq);
            sg_kloop(acc2, (const bf16_t*)(ws + WS_Z) + (size_t)GROWS * 2048, (const bf16_t*)(ws + WS_WBT), 2048, row0, col0, wave, fr, fq);
        } else if (mode == SM_OUT) {
            sg_kloop(acc, (const bf16_t*)(ws + WS_H) + (size_t)GROWS * 1024, (const bf16_t*)(ws + WS_WOT), 1024, row0, col0, wave, fr, fq);
        } else if (mode == SM_UP) {
            sg_kloop(acc, (const bf16_t*)(ws + WS_XB) + (size_t)GROWS * 1024, (const bf16_t*)(ws + WS_WUT), 1024, row0, col0, wave, fr, fq);
        } else if (mode == SM_DOWN) {
            sg_kloop(acc, (const bf16_t*)(ws + WS_GA) + (size_t)GROWS * 3072, (const bf16_t*)(ws + WS_WDT), 3072, row0, col0, wave, fr, fq);
        } else {
            sg_kloop(acc, (const bf16_t*)(ws + WS_XB) + (size_t)GROWS * 1024, (const bf16_t*)(ws + WS_WGT), 1024, row0, col0, wave, fr, fq);
            sg_kloop(acc2, (const bf16_t*)(ws + WS_PE1) + (size_t)GROWS * 256, (const bf16_t*)(ws + WS_WPT), 256, row0, col0, wave, fr, fq);
        }
        sg_reduce(acc, red, wave, lane);
        if (mode == SM_AB || mode == SM_PLE) sg_reduce(acc2, red, wave, lane);
        if (wave == 0) {
            const int r = row0 + fr, lr = GROWS + r;
            float rs = 1.f;
            if (mode == SM_AB) { const f32x4* sp = (const f32x4*)((const float*)(ws + WS_SSQ) + (size_t)lr * 32); float s = 0.f;
#pragma unroll
                for (int q4 = 0; q4 < 8; ++q4) { const f32x4 x = sp[q4]; s += (x[0] + x[1]) + (x[2] + x[3]); }
                rs = rsqrtf(s * (1.f / 2048.f) + EPS); }
            if (mode == SM_UP || mode == SM_PLE) { const f32x4* sp = (const f32x4*)((const float*)(ws + WS_SSX) + (size_t)lr * 16); float s = 0.f;
#pragma unroll
                for (int q4 = 0; q4 < 4; ++q4) { const f32x4 x = sp[q4]; s += (x[0] + x[1]) + (x[2] + x[3]); }
                rs = rsqrtf(s * (1.f / 1024.f) + EPS); }
            float ss = 0.f;
#pragma unroll
            for (int t = 0; t < 4; ++t) {
                const int c = col0 + 16 * t + 4 * fq;
                if (mode == SM_AB) {
                    const u32x2 ga = *(const u32x2*)((const bf16_t*)(ws + WS_GT) + (size_t)lr * 2048 + c), gb = *(const u32x2*)((const bf16_t*)(ws + WS_GT) + (size_t)lr * 2048 + 1024 + c);
                    const float g0[4] = {bflo(ga.x), bfhi(ga.x), bflo(ga.y), bfhi(ga.y)}, g1[4] = {bflo(gb.x), bfhi(gb.x), bflo(gb.y), bfhi(gb.y)};
                    float v[4];
#pragma unroll
                    for (int e = 0; e < 4; ++e) v[e] = bf2f((bf16_t)(pk2(g0[e] * acc[t][e], 0.f) & 0xffffu)) + g1[e] * rs * acc2[t][e];
                    u32x2 w; w.x = pk2(v[0], v[1]); w.y = pk2(v[2], v[3]);
                    *(u32x2*)((bf16_t*)(ws + WS_H) + (size_t)lr * 1024 + c) = w;
                } else if (mode == SM_OUT || mode == SM_DOWN) {
                    bf16_t* xbp = (bf16_t*)(ws + WS_XB) + (size_t)lr * 1024 + c;
                    f32x4 x;
                    if (mode == SM_OUT) x = *(const f32x4*)(P.in[I_XS] + (size_t)r * DM + c);
                    else { const u32x2 xw = *(const u32x2*)xbp; x = (f32x4){bflo(xw.x), bfhi(xw.x), bflo(xw.y), bfhi(xw.y)}; }
                    const f32x4 v = (f32x4){x[0] + acc[t][0], x[1] + acc[t][1], x[2] + acc[t][2], x[3] + acc[t][3]};
                    u32x2 w; w.x = pk2(v[0], v[1]); w.y = pk2(v[2], v[3]);
                    *(u32x2*)xbp = w;
                    ss += (v[0] * v[0] + v[1] * v[1]) + (v[2] * v[2] + v[3] * v[3]);
                } else if (mode == SM_UP) {
                    const f32x4 v = acc[t] * rs;
                    u32x2 w; w.x = pk2(v[0], v[1]); w.y = pk2(v[2], v[3]);
                    *(u32x2*)((bf16_t*)(ws + WS_U) + (size_t)lr * 6144 + c) = w;
                    const int bq = r >> 5, tq = r & 31;
                    if (tq >= 30) *(f32x4*)(P.out + O_CFS + ((size_t)bq * 2 + (tq - 30)) * 6144 + c) = v;
                } else {
                    float* yr = P.out + O_YS + (size_t)r * DM + c;
                    const u32x2 xw = *(const u32x2*)((const bf16_t*)(ws + WS_XB) + (size_t)lr * 1024 + c);
                    const f32x4 x = (f32x4){bflo(xw.x), bfhi(xw.x), bflo(xw.y), bfhi(xw.y)};
                    f32x4 v;
#pragma unroll
                    for (int e = 0; e < 4; ++e) v[e] = x[e] + bf2f((bf16_t)(pk2(sigmoidf_(acc[t][e] * rs), 0.f) & 0xffffu)) * acc2[t][e];
                    *(f32x4*)yr = v;
                }
            }
            if (mode == SM_OUT || mode == SM_DOWN) {
                ss += __shfl_xor(ss, 16); ss += __shfl_xor(ss, 32);
                if (fq == 0) {
                    ((float*)(ws + WS_SSX))[(size_t)lr * 16 + cb] = ss;
                }
            }
        }
    }
    asm volatile("s_waitcnt vmcnt(0)" ::: "memory"); __syncthreads();
}

__device__ __forceinline__ float gelu_tanh(float x) { const float u = 0.7978845608028654f * (x + 0.044715f * x * x * x); return x * __builtin_amdgcn_rcpf(1.f + __builtin_amdgcn_exp2f(-2.f * LOG2E * u)); }
__device__ __forceinline__ void ew_phase(const Params& P, int g, int wv) {
    const size_t gt = (size_t)lbid() * 512 + ltid_w(wv), GT = (size_t)gridDim.x * 512;
    unsigned char* ws = lws(P);
    const bf16_t* ub = (const bf16_t*)(ws + WS_U); bf16_t* ga = (bf16_t*)(ws + WS_GA);
    const size_t n = (size_t)(grows(g) / 8) * 384;
    for (size_t i = gt; i < n; i += GT) {
        const int rg = (int)(i / 384), c0 = (int)(i % 384) * 8, lr0 = rg * 8;
        int t0, sb = 0; const bool smp = lr0 >= GROWS; if (smp) { sb = (lr0 - GROWS) >> 5; t0 = (lr0 - GROWS) & 31; } else t0 = lr0 & 2047;
        float w[2][4][8];
#pragma unroll
        for (int hf = 0; hf < 2; ++hf)
#pragma unroll
            for (int k = 0; k < 4; ++k) { const float* wp = (k < 3 ? P.in[I_FCW] + k * 6144 : P.in[I_FCB]) + hf * 3072 + c0; const f32x4 a = *(const f32x4*)wp, b2 = *(const f32x4*)(wp + 4);
                w[hf][k][0] = a[0]; w[hf][k][1] = a[1]; w[hf][k][2] = a[2]; w[hf][k][3] = a[3]; w[hf][k][4] = b2[0]; w[hf][k][5] = b2[1]; w[hf][k][6] = b2[2]; w[hf][k][7] = b2[3]; }
        float pa[2][8], pb[2][8];
#pragma unroll
        for (int hf = 0; hf < 2; ++hf) {
            const int ch = hf * 3072 + c0;
#pragma unroll
            for (int k = 0; k < 2; ++k) {
                float* dst = k == 0 ? pa[hf] : pb[hf];
                if (t0 > 0) unpack8(*(const u32x4*)(ub + (size_t)(lr0 - 2 + k) * 6144 + ch), dst);
                else if (smp) { const float* cp = P.in[I_CFFN] + ((size_t)sb * 2 + k) * 6144 + ch; const f32x4 a = *(const f32x4*)cp, b2 = *(const f32x4*)(cp + 4); dst[0] = a[0]; dst[1] = a[1]; dst[2] = a[2]; dst[3] = a[3]; dst[4] = b2[0]; dst[5] = b2[1]; dst[6] = b2[2]; dst[7] = b2[3]; }
                else {
#pragma unroll
                    for (int e = 0; e < 8; ++e) dst[e] = 0.f;
                }
            }
        }
#pragma unroll
        for (int r = 0; r < 8; ++r) {
            float cur[2][8], res[2][8];
#pragma unroll
            for (int hf = 0; hf < 2; ++hf) {
                unpack8(*(const u32x4*)(ub + (size_t)(lr0 + r) * 6144 + hf * 3072 + c0), cur[hf]);
#pragma unroll
                for (int e = 0; e < 8; ++e) { res[hf][e] = w[hf][3][e] + w[hf][0][e] * pa[hf][e] + w[hf][1][e] * pb[hf][e] + w[hf][2][e] * cur[hf][e]; pa[hf][e] = pb[hf][e]; pb[hf][e] = cur[hf][e]; }
            }
            float o[8];
#pragma unroll
            for (int e = 0; e < 8; ++e) o[e] = gelu_tanh(res[0][e]) * res[1][e];
            *(u32x4*)(ga + (size_t)(lr0 + r) * 3072 + c0) = pack8(o);
        }
    }
}

#define XB_TMO      128
#define XB_XCNT(j)  (256  + 64 * (j))
#define XB_XSUB(j)  (1280 + 64 * (j))
#define XB_XGEN(j)  (2304 + 64 * (j))
#define XB_TOP      3328
#define XB_TOPGEN   3392
#define XCD_BAR_WORDS 3456
#define XB_SPIN_CAP (1u << 18)

__device__ __forceinline__ unsigned xb_ld(unsigned* p)              { return __hip_atomic_load(p, __ATOMIC_RELAXED, __HIP_MEMORY_SCOPE_AGENT); }
__device__ __forceinline__ unsigned xb_add(unsigned* p, unsigned v) { return __hip_atomic_fetch_add(p, v, __ATOMIC_RELAXED, __HIP_MEMORY_SCOPE_AGENT); }
__device__ __forceinline__ unsigned xb_xcc_id() { return (unsigned)__builtin_amdgcn_s_getreg((3 << 11) | 20) & 0xFu; }
#define XB_SPIN(cond, bar) do { unsigned _sp = 0; while (cond) { __builtin_amdgcn_s_sleep(1); \
    if ((++_sp & 255u) == 0u) { if (xb_ld(&(bar)[XB_TMO])) break; if (_sp > XB_SPIN_CAP) { atomicAdd(&(bar)[XB_TMO], 1u); break; } } } } while (0)

struct XcdBarrier {
    unsigned* bar; unsigned x;
    volatile LAS unsigned* st;
};

__device__ __forceinline__ XcdBarrier xcd_barrier_post(unsigned* bar, volatile LAS unsigned* st, int tid_) {
    XcdBarrier b; b.bar = bar; b.x = xb_xcc_id(); b.st = st;
    if (tid_ == 0) (void)xb_add(&bar[XB_XCNT(b.x)], 1u);
    return b;
}
__device__ __forceinline__ void xcd_barrier_complete(unsigned* bar, unsigned x, unsigned& nloc, unsigned& nx) {
    const unsigned G = gridDim.x * gridDim.y * gridDim.z;
    unsigned sum, cnt, mine, sp = 0u;
    for (;;) {
        sum = 0u; cnt = 0u; mine = 0u;
#pragma unroll
        for (unsigned j = 0; j < 16; ++j) { const unsigned c = xb_ld(&bar[XB_XCNT(j)]); sum += c; cnt += (c > 0u) ? 1u : 0u; mine = (j == x) ? c : mine; }
        if (sum == G) break;
        __builtin_amdgcn_s_sleep(1);
        if ((++sp & 255u) == 0u) { if (xb_ld(&bar[XB_TMO])) break; if (sp > XB_SPIN_CAP) { atomicAdd(&bar[XB_TMO], 1u); break; } }
    }
    nloc = mine > 0u ? mine : 1u; nx = cnt > 0u ? cnt : 1u;
}

__device__ __forceinline__ void xcd_barrier(const XcdBarrier& b, int tid_) {
    asm volatile("s_waitcnt vmcnt(0)" ::: "memory");
    __syncthreads();
    if (tid_ == 0) {
        unsigned* bar = b.bar;
        __builtin_amdgcn_s_waitcnt(0);
        unsigned nloc = b.st[0], nx = b.st[1];
        if (nloc == 0u) { xcd_barrier_complete(bar, b.x, nloc, nx); b.st[0] = nloc; b.st[1] = nx; }
        const unsigned old = xb_add(&bar[XB_XSUB(b.x)], 1u);
        const unsigned gen = old / nloc;
        if (old + 1u == (gen + 1u) * nloc) {
            __builtin_amdgcn_fence(__ATOMIC_RELEASE, "agent");
            asm volatile("s_waitcnt vmcnt(0)" ::: "memory");
            const unsigned og = xb_add(&bar[XB_TOP], 1u);
            const unsigned tg = og / nx;
            if (og + 1u == (tg + 1u) * nx) xb_add(&bar[XB_TOPGEN], 1u);
            else XB_SPIN(xb_ld(&bar[XB_TOPGEN]) == tg, bar);
            __builtin_amdgcn_fence(__ATOMIC_ACQUIRE, "agent");
            xb_add(&bar[XB_XGEN(b.x)], 1u);
            asm volatile("s_waitcnt vmcnt(0)" ::: "memory");
        } else {
            XB_SPIN(xb_ld(&bar[XB_XGEN(b.x)]) == gen, bar);
            __builtin_amdgcn_fence(__ATOMIC_ACQUIRE, "agent");
            asm volatile("s_waitcnt vmcnt(0)" ::: "memory");
        }
    }
    __syncthreads();
}


constexpr int NPHASE = 19;
__device__ __forceinline__ void gbar(unsigned* ctr, unsigned target, int tid) {
    asm volatile("s_waitcnt vmcnt(0)" ::: "memory");
    __syncthreads();
    if (tid == 0) {
        __builtin_amdgcn_fence(__ATOMIC_RELEASE, "agent");
        asm volatile("s_waitcnt vmcnt(0)" ::: "memory");
        __hip_atomic_fetch_add(ctr, 1u, __ATOMIC_RELAXED, __HIP_MEMORY_SCOPE_AGENT);
        while (__hip_atomic_load(ctr, __ATOMIC_RELAXED, __HIP_MEMORY_SCOPE_AGENT) < target) __builtin_amdgcn_s_sleep(1);
        __builtin_amdgcn_fence(__ATOMIC_ACQUIRE, "agent");
        asm volatile("s_waitcnt vmcnt(0)" ::: "memory");
    }
    __syncthreads();
}
#define PH_IN(k) (P.ph_lo <= (k) && (k) < P.ph_hi)
#define PH_SYNC(k) do { if (PH_IN(k) && PH_IN((k) + 1)) { xcd_barrier(xbar, ltid_w(wv)); } } while (0)
#define WSB(off) ((const bf16_t*)(lws(P) + (off)))
#define GROUP_PHASES(g, base, M) \
    if (PH_IN(base + 0)) run_gemm(lds, P, M_IN, g, WSB(g == 0 ? WS_H : WS_H1), WSB(WS_W1T), M, NINP, 1024, wv); PH_SYNC(base + 0); \
    if (PH_IN(base + 1)) bc_prepass(P, g, wv); PH_SYNC(base + 1); \
    if (PH_IN(base + 2)) mixer_phase(P, lds, g, wv); PH_SYNC(base + 2); \
    if (PH_IN(base + 3)) { if (g == 1) sample_stage(P, lds, SM_AB, wv); run_gemm(lds, P, M_PA, g, WSB(WS_Q), WSB(WS_WAT), GROWS, 1024, 1024, wv); run_gemm(lds, P, M_PB, g, WSB(WS_Z), WSB(WS_WBT), GROWS, 1024, 2048, wv); } PH_SYNC(base + 3); \
    if (PH_IN(base + 4)) { if (g == 1) sample_stage(P, lds, SM_OUT, wv); run_gemm(lds, P, M_OUT, g, WSB(WS_H), WSB(WS_WOT), GROWS, 1024, 1024, wv); } PH_SYNC(base + 4); \
    if (PH_IN(base + 5)) { if (g == 1) sample_stage(P, lds, SM_UP, wv); run_gemm(lds, P, M_UP, g, WSB(WS_XB), WSB(WS_WUT), GROWS, 6144, 1024, wv); } PH_SYNC(base + 5); \
    if (PH_IN(base + 6)) ew_phase(P, g, wv); PH_SYNC(base + 6); \
    if (PH_IN(base + 7)) { if (g == 1) sample_stage(P, lds, SM_DOWN, wv); run_gemm(lds, P, M_DOWN, g, WSB(WS_GA), WSB(WS_WDT), GROWS, 1024, 3072, wv); } PH_SYNC(base + 7); \
    if (PH_IN(base + 8)) { if (g == 1) sample_stage(P, lds, SM_PLE, wv); run_gemm(lds, P, M_PG, g, WSB(WS_XB), WSB(WS_WGT), GROWS, 1024, 1024, wv); run_gemm(lds, P, M_PLE, g, WSB(g == 0 ? WS_PE : WS_PE1), WSB(WS_WPT), GROWS, 1024, 256, wv); }
__global__ void __launch_bounds__(512, 2) fwd_kernel(Params P) {
    extern __shared__ __attribute__((aligned(16))) unsigned char lds_raw[];
    LAS unsigned char* lds = (LAS unsigned char*)lds_raw;
    cg::grid_group grid = cg::this_grid();
    int wv = __builtin_amdgcn_readfirstlane(threadIdx.x >> 6); asm volatile("" : "+s"(wv));
    if (P.ph_hi - P.ph_lo > 1) grid.sync();
    volatile LAS unsigned* xst = (volatile LAS unsigned*)(lds + 157184);
    { const int t0_ = ltid_w(wv); if (t0_ < 2) xst[t0_] = 0u; __syncthreads(); }
    XcdBarrier xbar = xcd_barrier_post((unsigned*)(lws(P) + 1024), xst, ltid_w(wv));
    if (PH_IN(0)) { prologue(P, lds, wv); norm_pass(P, 0, wv); norm_pass(P, 1, wv); }
    PH_SYNC(0);
    GROUP_PHASES(0, 1, GROWS)
    PH_SYNC(9);
    GROUP_PHASES(1, 10, TMAX)
}

#ifndef MULTI_LAUNCH
#define MULTI_LAUNCH 0
#endif
#ifdef DBG_SRC
__global__ void dbg_dump(const unsigned short* src, float* dst, size_t n) { for (size_t i = (size_t)blockIdx.x * blockDim.x + threadIdx.x; i < n; i += (size_t)gridDim.x * blockDim.x) dst[i] = bf2f(src[i]); }
#endif
extern "C" void kernel_launch(void* const* d_in, const int* in_sizes, int n_in, void* d_out, int out_size, void* d_ws, size_t ws_size, hipStream_t stream) {
    static int grid = 0;
    if (grid == 0) {
        if (n_in != 32 || ws_size < WS_END) { fprintf(stderr, "kernel_launch: unexpected n_in %d / ws_size %zu (need %zu)\n", n_in, ws_size, (size_t)WS_END); grid = -1; return; }
        int dev = 0, cus = 0, per_cu = 0;
        hipGetDevice(&dev); hipDeviceGetAttribute(&cus, hipDeviceAttributeMultiprocessorCount, dev);
        if (hipFuncSetAttribute((const void*)fwd_kernel, hipFuncAttributeMaxDynamicSharedMemorySize, LDS_BYTES) != hipSuccess) { fprintf(stderr, "hipFuncSetAttribute failed\n"); grid = -1; return; }
        if (hipOccupancyMaxActiveBlocksPerMultiprocessor(&per_cu, (const void*)fwd_kernel, 512, LDS_BYTES) != hipSuccess || per_cu < 1) { fprintf(stderr, "occupancy query: %d\n", per_cu); per_cu = 1; }
        (void)hipGetLastError();
        grid = cus * per_cu;
    }
    if (grid < 0) return;
    Params p{};
    for (int i = 0; i < 32; ++i) p.in[i] = (const float*)d_in[i];
    p.out = (float*)d_out; p.ws = (unsigned char*)d_ws;
#if MULTI_LAUNCH
#ifndef DBG_HI
#define DBG_HI NPHASE
#endif
    for (int ph = 0; ph < DBG_HI; ++ph) { p.ph_lo = ph; p.ph_hi = ph + 1; hipLaunchKernelGGL(fwd_kernel, dim3(grid), dim3(512), LDS_BYTES, stream, p); }
#ifdef DBG_SRC
    hipLaunchKernelGGL(dbg_dump, dim3(2048), dim3(256), 0, stream, (const unsigned short*)((unsigned char*)d_ws + (DBG_SRC)), (float*)d_out, (size_t)(DBG_N));
#endif
#else
    p.ph_lo = 0; p.ph_hi = NPHASE;
    (void)hipMemsetAsync(d_ws, 0, 16384, stream);
    void* args[] = {&p};
    hipError_t e = hipLaunchCooperativeKernel((const void*)fwd_kernel, dim3(grid), dim3(512), args, LDS_BYTES, stream);
    if (e != hipSuccess) fprintf(stderr, "cooperative launch failed: %s (grid %d)\n", hipGetErrorString(e), grid);
#endif
}
```

```cpp
#include <hip/hip_runtime.h>
#include <hip/hip_cooperative_groups.h>
#include <cstdio>
#include <cstdint>
namespace cg = cooperative_groups;
namespace pg8 {
#define PG8_LAS __attribute__((address_space(3)))
typedef unsigned short bf16_t;
typedef short bf16x8 __attribute__((ext_vector_type(8)));
typedef float f32x4 __attribute__((ext_vector_type(4)));
typedef unsigned u32x4 __attribute__((ext_vector_type(4)));
constexpr int BM = 256, BK = 64, HALF = 128, HTB = HALF * BK * 2  , STAGE_BYTES = 8 * HTB, NXCD = 8, WGM = 8;

__host__ __device__ __forceinline__ int lds_byte(int r, int c) { const int st = (r >> 4) * 2 + (c >> 5), rr = r & 15, cc = c & 31, ob = rr * 64 + cc * 2; return st * 1024 + (ob ^ (((ob >> 9) & 1) << 5)); }
__host__ __device__ __forceinline__ void stage_rc(int b, int& R, int& C) { const int st = b / 1024, sb = b % 1024, swz = sb ^ (((sb >> 9) & 1) << 5); R = (st >> 1) * 16 + swz / 64; C = (st & 1) * 32 + (swz % 64) / 2; }
__host__ __device__ __forceinline__ int perm32(int rho) { const int n = rho >> 4, i = rho & 15; return 8 * (i >> 2) + 4 * n + (i & 3); }

struct Unit { int pm, pn; };
struct Gemm { const bf16_t* A; const bf16_t* Bt; int M, N, K; };

struct StaticOrder {
    int nM, nN, nwg, G, c;
    __host__ __device__ __forceinline__ void init(int M, int N, int G_, int c_) { nM = M / BM; nN = N / BM; nwg = nM * nN; G = G_; c = c_; }
    __host__ __device__ __forceinline__ bool next(int i, Unit& u) const {
        const long L = (long)i * G + c; if (L >= nwg) return false;
        int wgid = (int)L; { const int q = nwg / NXCD, r = nwg % NXCD, xcd = wgid % NXCD, off = wgid / NXCD; wgid = (xcd < r ? xcd * (q + 1) : r * (q + 1) + (xcd - r) * q) + off; }
        const int nig = WGM * nN, gid = wgid / nig, fm = gid * WGM, gsz = (nM - fm) < WGM ? (nM - fm) : WGM;
        u.pm = fm + ((wgid % nig) % gsz); u.pn = (wgid % nig) / gsz; return true;
    }
    __device__ __forceinline__ void a_ready(const Unit&) const {}
    __device__ __forceinline__ void done(const Unit&) const {}
};

__device__ __forceinline__ unsigned cvt_pk_bf16(float lo, float hi) { unsigned r; asm volatile("v_cvt_pk_bf16_f32 %0, %1, %2" : "=v"(r) : "v"(lo), "v"(hi)); return r; }
template <class Epi, class Sched, bool ALIGN_EPI = false, bool SP2 = false>
__device__ __forceinline__ void gemm_phase(PG8_LAS unsigned char* lds, const Gemm g, const Sched& S, const Epi& E, int tid_in) {
    int tid_l = tid_in; asm volatile("" : "+v"(tid_l)); const int tid = tid_l, wid = __builtin_amdgcn_readfirstlane(tid >> 6), lane = tid & 63, wr = wid >> 2, wc = wid & 3, fr = lane & 15, fq = lane >> 4;
    const int K = g.K, nt = K / BK;
    unsigned voffA[2], voffB[2];
#pragma unroll
    for (int i = 0; i < 2; ++i) { int R, C; stage_rc(tid * 16 + i * 8192, R, C); const int Rb = Epi::PERM ? ((R & ~31) + perm32(R & 31)) : R;
        voffA[i] = (unsigned)(R * K + C) * 2u; voffB[i] = (unsigned)(Rb * K + C) * 2u; }
    const size_t kstep = (size_t)(BK * 2);
    const size_t hstep = (size_t)HALF * K * 2;
    const size_t tstep = 2 * hstep;
    const unsigned ldsw = (unsigned)wid * 1024u;
    const int aoff = lds_byte(wr * 64 + fr, fq * 8), boff = lds_byte(wc * 32 + fr, fq * 8);
#define PG8_SA(b, h) (((b) * 2 + (h)) * HTB)
#define PG8_SB(b, h) ((4 + (b) * 2 + (h)) * HTB)
#define PG8_STAGE(bufoff, gbase, voff) do { _Pragma("unroll") for (int _i = 0; _i < 2; ++_i) \
        __builtin_amdgcn_global_load_lds((const unsigned*)((const char*)(gbase) + (voff)[_i]), (PG8_LAS unsigned*)(lds + (bufoff) + ldsw + _i * 8192), 16, 0, 0); } while (0)
#define PG8_LDA(dst, b, h) do { _Pragma("unroll") for (int m = 0; m < 4; ++m) _Pragma("unroll") for (int k = 0; k < 2; ++k) dst[m][k] = *(const PG8_LAS bf16x8*)(lds + PG8_SA(b, h) + aoff + m * 2048 + k * 1024); } while (0)
#define PG8_LDB(dst, b, h) do { _Pragma("unroll") for (int n = 0; n < 2; ++n) _Pragma("unroll") for (int k = 0; k < 2; ++k) dst[n][k] = *(const PG8_LAS bf16x8*)(lds + PG8_SB(b, h) + boff + n * 2048 + k * 1024); } while (0)
#define PG8_MMA(ai, bj, At, Bt) do { __builtin_amdgcn_s_setprio(1); _Pragma("unroll") for (int m = 0; m < 4; ++m) _Pragma("unroll") for (int n = 0; n < 2; ++n) _Pragma("unroll") for (int k = 0; k < 2; ++k) \
        acc[ai][bj][m][n] = __builtin_amdgcn_mfma_f32_16x16x32_bf16(Bt[n][k], At[m][k], acc[ai][bj][m][n], 0, 0, 0); __builtin_amdgcn_s_setprio(0); } while (0)
#define PG8_WAIT_V(n) asm volatile("s_waitcnt vmcnt(" #n ")" ::: "memory")
#define PG8_WAIT_L(n) asm volatile("s_waitcnt lgkmcnt(" #n ")" ::: "memory")
#define PG8_BAR __builtin_amdgcn_s_barrier()
#define PG8_SCHED __builtin_amdgcn_sched_barrier(0)
    Unit cur, nxt; int ui = 0;
    if (!S.next(0, cur)) return;
    f32x4 acc[2][2][4][2];
#pragma unroll
    for (int a = 0; a < 2; ++a)
#pragma unroll
        for (int b = 0; b < 2; ++b)
#pragma unroll
            for (int m = 0; m < 4; ++m)
#pragma unroll
                for (int n = 0; n < 2; ++n) acc[a][b][m][n] = (f32x4){0.f, 0.f, 0.f, 0.f};
    bf16x8 At[4][2], B0[2][2], B1[2][2];
    const char* cA = (const char*)g.A + (size_t)cur.pm * tstep; const char* cB = (const char*)g.Bt + (size_t)cur.pn * tstep;
    S.a_ready(cur);
    if constexpr (SP2) {
        PG8_STAGE(PG8_SB(0, 0), cB, voffB); PG8_STAGE(PG8_SB(0, 1), cB + hstep, voffB); PG8_STAGE(PG8_SA(0, 0), cA, voffA); PG8_STAGE(PG8_SA(0, 1), cA + hstep, voffA);
        if (wr == 1) PG8_BAR;
        PG8_WAIT_V(2); PG8_BAR;
        PG8_STAGE(PG8_SB(1, 0), cB + kstep, voffB); PG8_STAGE(PG8_SA(1, 0), cA + kstep, voffA); PG8_STAGE(PG8_SB(1, 1), cB + hstep + kstep, voffB);
        PG8_WAIT_V(6); PG8_BAR;
    } else {
        PG8_STAGE(PG8_SB(0, 0), cB, voffB); PG8_STAGE(PG8_SA(0, 0), cA, voffA); PG8_STAGE(PG8_SB(0, 1), cB + hstep, voffB); PG8_STAGE(PG8_SA(0, 1), cA + hstep, voffA);
        if (wr == 1) PG8_BAR;
        PG8_WAIT_V(4); PG8_BAR;
        PG8_STAGE(PG8_SB(1, 0), cB + kstep, voffB); PG8_STAGE(PG8_SA(1, 0), cA + kstep, voffA); PG8_STAGE(PG8_SB(1, 1), cB + hstep + kstep, voffB);
        PG8_WAIT_V(6); PG8_BAR;
    }
    for (;;) {
        const bool has_next = S.next(ui + 1, nxt);
        const char* nA = has_next ? (const char*)g.A + (size_t)nxt.pm * tstep : cA; const char* nB = has_next ? (const char*)g.Bt + (size_t)nxt.pn * tstep : cB;
        for (int t = 0; t < nt; t += 2) {
            const bool last = (t == nt - 2);
            const char* a1 = cA + (size_t)(t + 1) * kstep;
            const char* a2 = last ? nA : cA + (size_t)(t + 2) * kstep; const char* b2 = last ? nB : cB + (size_t)(t + 2) * kstep;
            const char* a3 = a2 + kstep; const char* b3 = b2 + kstep;
            if (last && has_next) S.a_ready(nxt);
            if constexpr (SP2) {
            PG8_LDB(B0, 0, 0); PG8_LDB(B1, 0, 1); PG8_SCHED; PG8_LDA(At, 0, 0); PG8_STAGE(PG8_SA(1, 1), a1 + hstep, voffA);
            PG8_WAIT_V(8); PG8_WAIT_L(0); PG8_BAR; PG8_MMA(0, 0, At, B0); PG8_MMA(0, 1, At, B1); PG8_BAR; PG8_SCHED;
            PG8_LDA(At, 0, 1); PG8_STAGE(PG8_SB(0, 0), b2, voffB); PG8_STAGE(PG8_SB(0, 1), b2 + hstep, voffB); PG8_STAGE(PG8_SA(0, 0), a2, voffA);
            PG8_WAIT_V(8); PG8_WAIT_L(0); PG8_BAR; PG8_MMA(1, 0, At, B0); PG8_MMA(1, 1, At, B1); PG8_BAR; PG8_SCHED;
            PG8_LDB(B0, 1, 0); PG8_LDB(B1, 1, 1); PG8_SCHED; PG8_LDA(At, 1, 0); PG8_STAGE(PG8_SA(0, 1), a2 + hstep, voffA);
            PG8_WAIT_V(8); PG8_WAIT_L(0); PG8_BAR; PG8_MMA(0, 0, At, B0); PG8_MMA(0, 1, At, B1); PG8_BAR; PG8_SCHED;
            PG8_LDA(At, 1, 1); PG8_STAGE(PG8_SB(1, 0), b3, voffB); PG8_STAGE(PG8_SB(1, 1), b3 + hstep, voffB); PG8_STAGE(PG8_SA(1, 0), a3, voffA);
            PG8_WAIT_V(8); PG8_WAIT_L(0); PG8_BAR; PG8_MMA(1, 0, At, B0); PG8_MMA(1, 1, At, B1); PG8_BAR; PG8_SCHED;
            } else {
            PG8_LDB(B0, 0, 0); PG8_SCHED; PG8_LDA(At, 0, 0); PG8_STAGE(PG8_SA(1, 1), a1 + hstep, voffA);
            PG8_WAIT_L(8); PG8_BAR; PG8_WAIT_L(0); PG8_MMA(0, 0, At, B0); PG8_BAR; PG8_SCHED;
            PG8_LDB(B1, 0, 1); PG8_STAGE(PG8_SB(0, 0), b2, voffB);
            PG8_BAR; PG8_WAIT_L(0); PG8_MMA(0, 1, At, B1); PG8_BAR;
            PG8_LDA(At, 0, 1); PG8_STAGE(PG8_SA(0, 0), a2, voffA);
            PG8_BAR; PG8_WAIT_L(0); PG8_MMA(1, 0, At, B0); PG8_BAR; PG8_SCHED;
            PG8_STAGE(PG8_SB(0, 1), b2 + hstep, voffB);
            PG8_WAIT_V(6); PG8_BAR; PG8_MMA(1, 1, At, B1); PG8_BAR;
            PG8_LDB(B0, 1, 0); PG8_SCHED; PG8_LDA(At, 1, 0); PG8_STAGE(PG8_SA(0, 1), a2 + hstep, voffA);
            PG8_WAIT_L(8); PG8_BAR; PG8_WAIT_L(0); PG8_MMA(0, 0, At, B0); PG8_BAR; PG8_SCHED;
            PG8_LDB(B1, 1, 1); PG8_STAGE(PG8_SB(1, 0), b3, voffB);
            PG8_BAR; PG8_WAIT_L(0); PG8_MMA(0, 1, At, B1); PG8_BAR;
            PG8_LDA(At, 1, 1); PG8_STAGE(PG8_SA(1, 0), a3, voffA);
            PG8_BAR; PG8_WAIT_L(0); PG8_MMA(1, 0, At, B0); PG8_BAR; PG8_SCHED;
            PG8_STAGE(PG8_SB(1, 1), b3 + hstep, voffB);
            PG8_WAIT_V(6); PG8_BAR; PG8_MMA(1, 1, At, B1); PG8_BAR;
            }
        }
        if constexpr (ALIGN_EPI) { if (wr == 0) PG8_BAR; }
        if constexpr (!Epi::AFTER_DRAIN) { E(acc, cur, wr, wc, fr, fq); S.done(cur); }
        if (!has_next) break;
#pragma unroll
        for (int a = 0; a < 2; ++a)
#pragma unroll
            for (int b = 0; b < 2; ++b)
#pragma unroll
                for (int m = 0; m < 4; ++m)
#pragma unroll
                    for (int n = 0; n < 2; ++n) acc[a][b][m][n] = (f32x4){0.f, 0.f, 0.f, 0.f};
        cur = nxt; cA = nA; cB = nB; ++ui;
        if constexpr (ALIGN_EPI) { if (wr == 1) PG8_BAR; }
    }
    PG8_WAIT_V(0);
    if constexpr (!ALIGN_EPI) { if (wr == 0) PG8_BAR; }
    PG8_BAR;
    if constexpr (Epi::AFTER_DRAIN) { E.fused(acc, cur, wr, wc, fr, fq, lds, wid, lane); S.done(cur); }
#undef PG8_SA
#undef PG8_SB
#undef PG8_STAGE
#undef PG8_LDA
#undef PG8_LDB
#undef PG8_MMA
#undef PG8_WAIT_V
#undef PG8_WAIT_L
#undef PG8_BAR
#undef PG8_SCHED
}
}

#define LAS __attribute__((address_space(3)))
typedef unsigned short bf16_t;
typedef short bf16x8 __attribute__((ext_vector_type(8)));
typedef short s16x4 __attribute__((ext_vector_type(4)));
typedef float f32x4 __attribute__((ext_vector_type(4)));
typedef unsigned u32x4 __attribute__((ext_vector_type(4)));
typedef unsigned u32x2 __attribute__((ext_vector_type(2)));

constexpr int DM = 1024, SEQ = 2048, NHA = 16, NHS = 32, CONVD = 3072, DFF = 3072, PLE = 256;
constexpr int NIN = 10272, NINP = 41 * 256;
constexpr int GROWS = 16384, TMAX = 16640;
constexpr float EPS = 1e-6f, LOG2E = 1.4426950408889634f, QSCALE = 0.125f * 1.4426950408889634f;

constexpr size_t O_YP = 0, O_YS = 33554432, O_KP = O_YS + 262144, O_VP = O_KP + 8388608, O_SSMP = O_VP + 8388608, O_CSP = O_SSMP + 4194304,
                 O_CFP = O_CSP + 147456, O_KS = O_CFP + 196608, O_VS = O_KS + 262144, O_SSMS = O_VS + 262144, O_CSS = O_SSMS + 2097152, O_CFS = O_CSS + 73728;

constexpr size_t al256(size_t x) { return (x + 255) & ~(size_t)255; }
constexpr size_t WS_W1T = 65536;
constexpr size_t WS_WAT = WS_W1T + (size_t)NINP * 1024 * 2;
constexpr size_t WS_WBT = WS_WAT + (size_t)1024 * 1024 * 2;
constexpr size_t WS_WOT = WS_WBT + (size_t)1024 * 2048 * 2;
constexpr size_t WS_WUT = WS_WOT + (size_t)1024 * 1024 * 2;
constexpr size_t WS_WDT = WS_WUT + (size_t)6144 * 1024 * 2;
constexpr size_t WS_WGT = WS_WDT + (size_t)1024 * 3072 * 2;
constexpr size_t WS_WPT = WS_WGT + (size_t)1024 * 1024 * 2;
constexpr size_t WS_KS  = WS_WPT + (size_t)1024 * 256 * 2;
constexpr size_t WS_VTS = WS_KS + (size_t)8 * 576 * 1024 * 2;
constexpr size_t WS_SSQ = WS_VTS + (size_t)8 * 576 * 1024 * 2;
constexpr size_t WS_SSX = WS_SSQ + al256((size_t)TMAX * 32 * 4);
constexpr size_t WS_H   = WS_SSX + al256((size_t)TMAX * 16 * 4);
constexpr size_t WS_Q   = WS_H + (size_t)TMAX * 1024 * 2;
constexpr size_t WS_K   = WS_Q + (size_t)TMAX * 1024 * 2;
constexpr size_t WS_VT  = WS_K + (size_t)TMAX * 1024 * 2;
constexpr size_t WS_Z   = WS_VT + (size_t)8 * 1024 * 2048 * 2;
constexpr size_t WS_XBC = WS_Z + (size_t)TMAX * 2048 * 2;
constexpr size_t WS_GT  = WS_XBC + (size_t)TMAX * 3072 * 2;
constexpr size_t WS_DT  = WS_GT + (size_t)TMAX * 2048 * 2;
constexpr size_t WS_PE  = WS_DT + (size_t)TMAX * 32 * 4;
constexpr size_t WS_PE1 = WS_PE + (size_t)TMAX * 256 * 2;
constexpr size_t WS_H1  = WS_PE1 + (size_t)TMAX * 256 * 2;
constexpr size_t WS_END = WS_H1 + (size_t)TMAX * 1024 * 2;
constexpr size_t WS_U   = WS_K;
constexpr size_t WS_GA  = WS_U + (size_t)TMAX * 6144 * 2;
constexpr size_t WS_ST  = WS_H;
constexpr size_t WS_XB  = WS_Q;
static_assert(WS_GA + (size_t)TMAX * 3072 * 2 <= WS_PE, "ffn overlay");
static_assert(WS_END <= (size_t)512 * 1024 * 1024, "ws budget");

constexpr int LDS_BYTES = 157696;

struct Params { const float* in[32]; float* out; unsigned char* ws; int ph_lo, ph_hi; };

enum { I_XP = 0, I_XS, I_CK, I_CV, I_SSM, I_CSSM, I_CFFN, I_PP, I_PS, I_GMIX, I_WIN, I_BGATE, I_GQ, I_GK, I_REL, I_CSW, I_CSB, I_DTB, I_ALOG, I_DSKIP, I_GSSM,
       I_WPA, I_WPB, I_WOUT, I_GFFN, I_WUP, I_FCW, I_FCB, I_WDOWN, I_GPLE, I_WPG, I_WPLE };

__device__ __forceinline__ int ltid_w(int wv) { int t = wv * 64 + (int)__builtin_amdgcn_mbcnt_hi(~0u, __builtin_amdgcn_mbcnt_lo(~0u, 0u)); asm volatile("" : "+v"(t)); return t; }
__device__ __forceinline__ int lbid() { int t = blockIdx.x; asm volatile("" : "+s"(t)); return t; }
__device__ __forceinline__ unsigned char* lws(const struct Params& P);
typedef float f32x2_t __attribute__((ext_vector_type(2))); typedef __bf16 bf16x2_t __attribute__((ext_vector_type(2)));
__device__ __forceinline__ unsigned pk2(float lo, float hi) { f32x2_t v = {lo, hi}; bf16x2_t r = __builtin_convertvector(v, bf16x2_t); return __builtin_bit_cast(unsigned, r); }
__device__ __forceinline__ float bf2f(unsigned short b) { return __uint_as_float(((unsigned)b) << 16); }
__device__ __forceinline__ float bflo(unsigned w) { return __uint_as_float(w << 16); }
__device__ __forceinline__ float bfhi(unsigned w) { return __uint_as_float(w & 0xffff0000u); }
__device__ __forceinline__ float sigmoidf_(float x) { return __builtin_amdgcn_rcpf(1.f + __builtin_amdgcn_exp2f(-LOG2E * x)); }
__device__ __forceinline__ float siluf_(float x) { return x * __builtin_amdgcn_rcpf(1.f + __builtin_amdgcn_exp2f(-LOG2E * x)); }
__device__ __forceinline__ float wave_sum(float v) {
#pragma unroll
    for (int o = 1; o < 64; o <<= 1) v += __shfl_xor(v, o);
    return v;
}
__device__ __forceinline__ u32x4 pack8(const float* v) { u32x4 w; w.x = pk2(v[0], v[1]); w.y = pk2(v[2], v[3]); w.z = pk2(v[4], v[5]); w.w = pk2(v[6], v[7]); return w; }
__device__ __forceinline__ void unpack8(u32x4 w, float* v) { v[0] = bflo(w.x); v[1] = bfhi(w.x); v[2] = bflo(w.y); v[3] = bfhi(w.y); v[4] = bflo(w.z); v[5] = bfhi(w.z); v[6] = bflo(w.w); v[7] = bfhi(w.w); }

__device__ __forceinline__ unsigned char* lws(const Params& P) { int z = 0; asm volatile("" : "+s"(z)); return P.ws + z; }
__device__ __forceinline__ const float* xrow(const Params& P, int g, int lr) { return lr < GROWS ? P.in[I_XP] + ((size_t)g * GROWS + lr) * DM : P.in[I_XS] + (size_t)(lr - GROWS) * DM; }
__device__ __forceinline__ float* yrow(const Params& P, int g, int lr) { return lr < GROWS ? P.out + O_YP + ((size_t)g * GROWS + lr) * DM : P.out + O_YS + (size_t)(lr - GROWS) * DM; }
__device__ __forceinline__ int grows(int g) { return g == 0 ? GROWS : TMAX; }

enum { M_IN = 0, M_PA, M_PB, M_OUT, M_UP, M_DOWN, M_PG, M_PLE };
struct Epi {
    static constexpr bool PERM = true, AFTER_DRAIN = false;
    const float *xp, *xs, *gq, *gk, *bgate, *dtb; float* out; unsigned char* wsb; int mode; int g; const LAS float* ev; int rsb;
    __device__ __forceinline__ void operator()(const f32x4 (&acc)[2][2][4][2], const pg8::Unit& u, int wr, int wc, int fr_, int fq_) const {
        int fr = fr_, fq = fq_; asm volatile("" : "+v"(fr), "+v"(fq));
        const int lane_ = fr + 16 * fq;
        unsigned char* ws = wsb;
        const int r0 = wr * 64 + fr;
        const int cb = wc * 32 + fq * 8;
        const bool smp = (u.pm == 64);
        if (mode == M_IN) {
            const int pn = u.pn;
            if (pn < 8) {
                const bool isk = pn >= 4; const int head = 4 * (pn & 3) + wc;
                const LAS float* gw = ev + (isk ? 64 : 0);
                float gv[2][8];
#pragma unroll
                for (int bj = 0; bj < 2; ++bj)
#pragma unroll
                    for (int e = 0; e < 8; ++e) gv[bj][e] = gw[32 * bj + 8 * fq + e];
#pragma unroll
                for (int ai = 0; ai < 2; ++ai)
#pragma unroll
                    for (int m = 0; m < 4; ++m) {
                        const int r = ai * 128 + m * 16 + r0; const int lr = u.pm * 256 + r;
                        float ss = 0.f;
#pragma unroll
                        for (int bj = 0; bj < 2; ++bj)
#pragma unroll
                            for (int n = 0; n < 2; ++n) { const f32x4 x = acc[ai][bj][m][n]; ss += x[0] * x[0] + x[1] * x[1] + x[2] * x[2] + x[3] * x[3]; }
                        ss += __shfl_xor(ss, 16); ss += __shfl_xor(ss, 32);
                        const float rs = rsqrtf(ss * (1.f / 64.f) + EPS);
                        int b, t; if (smp) { b = r >> 5; t = r & 31; } else { b = g * 8 + (u.pm >> 3); t = (u.pm & 7) * 256 + r; }
#pragma unroll
                        for (int bj = 0; bj < 2; ++bj) {
                            float v[8];
#pragma unroll
                            for (int e = 0; e < 8; ++e) v[e] = acc[ai][bj][m][e >> 2][e & 3] * rs * gv[bj][e];
                            const int col = head * 64 + 32 * bj + 8 * fq;
                            if (!isk) {
#pragma unroll
                                for (int e = 0; e < 8; ++e) v[e] *= QSCALE;
                                *(u32x4*)((bf16_t*)(ws + WS_Q) + (size_t)lr * 1024 + col) = pack8(v);
                            } else {
                                const int tk = smp ? 512 + t : t;
                                bf16_t* dst = (smp ? (bf16_t*)(ws + WS_KS) + ((size_t)b * 16 + head) * 576 * 64 : (bf16_t*)(ws + WS_K) + ((size_t)(u.pm >> 3) * 16 + head) * 2048 * 64)
                                              + (size_t)(tk >> 4) * 1024 + bj * 512 + fq * 128 + (tk & 15) * 8;
                                *(u32x4*)dst = pack8(v);
                                float* o = nullptr;
                                if (smp) o = out + O_KS + ((size_t)b * 32 + t) * 1024 + col; else if (t >= 1536) o = out + O_KP + ((size_t)b * 512 + (t - 1536)) * 1024 + col;
                                if (o) { *(f32x4*)o = (f32x4){v[0], v[1], v[2], v[3]}; *(f32x4*)(o + 4) = (f32x4){v[4], v[5], v[6], v[7]}; }
                            }
                        }
                    }
            } else if (pn < 12) {
#pragma unroll
                for (int ai = 0; ai < 2; ++ai)
#pragma unroll
                    for (int m = 0; m < 4; ++m) {
                        const int r = ai * 128 + m * 16 + r0;
                        int b, t; if (smp) { b = r >> 5; t = r & 31; } else { b = g * 8 + (u.pm >> 3); t = (u.pm & 7) * 256 + r; }
#pragma unroll
                        for (int bj = 0; bj < 2; ++bj) {
                            const int ch = (pn - 8) * 256 + bj * 128 + cb;
                            const int tt_ = smp ? 512 + t : t, j = fr & 3;
                            float v[8];
#pragma unroll
                            for (int e = 0; e < 8; ++e) v[e] = acc[ai][bj][m][e >> 2][e & 3];
                            const unsigned p0 = pk2(v[0], v[1]), p1 = pk2(v[2], v[3]), p2 = pk2(v[4], v[5]), p3 = pk2(v[6], v[7]);
                            unsigned got[4];
#pragma unroll
                            for (int r = 0; r < 4; ++r) { const int si = (j - r) & 3; const unsigned send = si == 0 ? p0 : (si == 1 ? p1 : (si == 2 ? p2 : p3)); got[r] = (unsigned)__shfl((int)send, (lane_ & ~3) | ((j + r) & 3)); }
                            unsigned tk[4];
#pragma unroll
                            for (int k = 0; k < 4; ++k) { const int gi = (k - j) & 3; tk[k] = gi == 0 ? got[0] : (gi == 1 ? got[1] : (gi == 2 ? got[2] : got[3])); }
                            u32x4 w; w.x = (tk[0] & 0xffffu) | (tk[1] << 16); w.y = (tk[2] & 0xffffu) | (tk[3] << 16); w.z = (tk[0] >> 16) | (tk[1] & 0xffff0000u); w.w = (tk[2] >> 16) | (tk[3] & 0xffff0000u);
                            *(u32x4*)((smp ? (bf16_t*)(ws + WS_VTS) + (size_t)b * 576 * 1024 : (bf16_t*)(ws + WS_VT) + (size_t)(u.pm >> 3) * 2048 * 1024) + ((size_t)((tt_ - j) >> 2) * 1024 + ch + 2 * j) * 4) = w;
                            float* o = nullptr;
                            if (smp) o = out + O_VS + ((size_t)b * 32 + t) * 1024 + ch; else if (t >= 1536) o = out + O_VP + ((size_t)b * 512 + (t - 1536)) * 1024 + ch;
                            if (o) { *(f32x4*)o = (f32x4){v[0], v[1], v[2], v[3]}; *(f32x4*)(o + 4) = (f32x4){v[4], v[5], v[6], v[7]}; }
                        }
                    }
            } else if (pn < 40) {
                const int kind = pn < 20 ? 0 : (pn < 32 ? 1 : 2);
                const int ct0 = (kind == 0 ? (pn - 12) : kind == 1 ? (pn - 20) : (pn - 32)) * 256;
                const int ld = kind == 1 ? 3072 : 2048;
                bf16_t* base = (bf16_t*)(ws + (kind == 0 ? WS_Z : kind == 1 ? WS_XBC : WS_GT));
                float bv[2][8];
#pragma unroll
                for (int bj = 0; bj < 2; ++bj)
#pragma unroll
                    for (int e = 0; e < 8; ++e) bv[bj][e] = kind == 2 ? ev[256 + ct0 + bj * 128 + cb + e] : 0.f;
#pragma unroll
                for (int ai = 0; ai < 2; ++ai)
#pragma unroll
                    for (int m = 0; m < 4; ++m) {
                        const int r = ai * 128 + m * 16 + r0; const int lr = u.pm * 256 + r;
                        int b, t, len; if (smp) { b = r >> 5; t = r & 31; len = 32; } else { b = g * 8 + (u.pm >> 3); t = (u.pm & 7) * 256 + r; len = 2048; }
#pragma unroll
                        for (int bj = 0; bj < 2; ++bj) {
                            const int col = ct0 + bj * 128 + cb;
                            float v[8];
#pragma unroll
                            for (int e = 0; e < 8; ++e) { float x = acc[ai][bj][m][e >> 2][e & 3]; v[e] = kind == 2 ? sigmoidf_(x + bv[bj][e]) : x; }
                            *(u32x4*)(base + (size_t)lr * ld + col) = pack8(v);
                            if (kind == 1 && t >= len - 3) {
                                float* o = smp ? out + O_CSS + ((size_t)b * 3 + (t - 29)) * 3072 + col : out + O_CSP + ((size_t)b * 3 + (t - 2045)) * 3072 + col;
                                *(f32x4*)o = (f32x4){v[0], v[1], v[2], v[3]}; *(f32x4*)(o + 4) = (f32x4){v[4], v[5], v[6], v[7]};
                            }
                        }
                    }
            } else {
                if (wc == 0) {
                    float db[8];
#pragma unroll
                    for (int e = 0; e < 8; ++e) db[e] = ev[128 + 8 * fq + e];
#pragma unroll
                    for (int ai = 0; ai < 2; ++ai)
#pragma unroll
                        for (int m = 0; m < 4; ++m) {
                            const int lr = u.pm * 256 + ai * 128 + m * 16 + r0;
                            float v[8];
#pragma unroll
                            for (int e = 0; e < 8; ++e) { const float x = acc[ai][0][m][e >> 2][e & 3] + db[e]; v[e] = x > 20.f ? x : log1pf(__expf(x)); }
                            float* o = (float*)(ws + WS_DT) + (size_t)lr * 32 + 8 * fq;
                            *(f32x4*)o = (f32x4){v[0], v[1], v[2], v[3]}; *(f32x4*)(o + 4) = (f32x4){v[4], v[5], v[6], v[7]};
                        }
                }
            }
            return;
        }
#pragma unroll
        for (int ai = 0; ai < 2; ++ai)
#pragma unroll
            for (int m = 0; m < 4; ++m) {
                const int r = ai * 128 + m * 16 + r0; const int lr = u.pm * 256 + r;
                float rs = 1.f, rss = 0.f;
                const bool rs_lds = (mode == M_PB || mode == M_UP || mode == M_PG) && ((u.pm >> 3) << 3) == rsb;
                if (rs_lds) rs = ev[(u.pm & 7) * 256 + r];
                if (!rs_lds && (mode == M_UP || mode == M_PG)) { const f32x4* sp = (const f32x4*)((const float*)(ws + WS_SSX) + (size_t)lr * 16); float s = 0.f;
#pragma unroll
                    for (int q4 = 0; q4 < 4; ++q4) { const f32x4 x = sp[q4]; s += (x[0] + x[1]) + (x[2] + x[3]); }
                    rs = rsqrtf(s * (1.f / 1024.f) + EPS); }
                if (!rs_lds && mode == M_PB) { const f32x4* sp = (const f32x4*)((const float*)(ws + WS_SSQ) + (size_t)lr * 32); float s = 0.f;
#pragma unroll
                    for (int q4 = 0; q4 < 8; ++q4) { const f32x4 x = sp[q4]; s += (x[0] + x[1]) + (x[2] + x[3]); }
                    rs = rsqrtf(s * (1.f / 2048.f) + EPS); }
#pragma unroll
                for (int bj = 0; bj < 2; ++bj) {
                    const int col = u.pn * 256 + bj * 128 + cb;
                    float a[8];
#pragma unroll
                    for (int e = 0; e < 8; ++e) a[e] = acc[ai][bj][m][e >> 2][e & 3];
                    if (mode == M_PA || mode == M_PB) {
                        bf16_t* mp = (bf16_t*)(ws + WS_H) + (size_t)lr * 1024 + col;
                        float gt[8]; unpack8(*(const u32x4*)((const bf16_t*)(ws + WS_GT) + (size_t)lr * 2048 + (mode == M_PB ? 1024 : 0) + col), gt);
                        float v[8];
                        if (mode == M_PA) {
#pragma unroll
                            for (int e = 0; e < 8; ++e) v[e] = gt[e] * a[e];
                        } else {
                            float s[8]; unpack8(*(const u32x4*)mp, s);
#pragma unroll
                            for (int e = 0; e < 8; ++e) v[e] = s[e] + gt[e] * rs * a[e];
                        }
                        *(u32x4*)mp = pack8(v);
                    } else if (mode == M_OUT || mode == M_DOWN) {
                        bf16_t* xbp = (bf16_t*)(ws + WS_XB) + (size_t)lr * 1024 + col;
                        float v[8];
                        if (mode == M_OUT) {
                            const float* xr = (lr < GROWS ? xp + ((size_t)g * GROWS + lr) * DM : xs + (size_t)(lr - GROWS) * DM) + col;
                            const f32x4 x0 = *(const f32x4*)xr, x1 = *(const f32x4*)(xr + 4);
                            v[0] = x0[0]; v[1] = x0[1]; v[2] = x0[2]; v[3] = x0[3]; v[4] = x1[0]; v[5] = x1[1]; v[6] = x1[2]; v[7] = x1[3];
                        } else unpack8(*(const u32x4*)xbp, v);
#pragma unroll
                        for (int e = 0; e < 8; ++e) v[e] += a[e];
                        *(u32x4*)xbp = pack8(v);
#pragma unroll
                        for (int e = 0; e < 8; ++e) rss += v[e] * v[e];
                    } else if (mode == M_UP) {
#pragma unroll
                        for (int e = 0; e < 8; ++e) a[e] *= rs;
                        *(u32x4*)((bf16_t*)(ws + WS_U) + (size_t)lr * 6144 + col) = pack8(a);
                        int b, t, len; if (smp) { b = r >> 5; t = r & 31; len = 32; } else { b = g * 8 + (u.pm >> 3); t = (u.pm & 7) * 256 + r; len = 2048; }
                        if (t >= len - 2) {
                            float* o = smp ? out + O_CFS + ((size_t)b * 2 + (t - 30)) * 6144 + col : out + O_CFP + ((size_t)b * 2 + (t - 2046)) * 6144 + col;
                            *(f32x4*)o = (f32x4){a[0], a[1], a[2], a[3]}; *(f32x4*)(o + 4) = (f32x4){a[4], a[5], a[6], a[7]};
                        }
                    } else if (mode == M_PG) {
                        float v[8];
#pragma unroll
                        for (int e = 0; e < 8; ++e) v[e] = sigmoidf_(a[e] * rs);
                        *(u32x4*)((bf16_t*)(ws + WS_ST) + (size_t)lr * 1024 + col) = pack8(v);
                    } else {
                        float s[8]; unpack8(*(const u32x4*)((const bf16_t*)(ws + WS_ST) + (size_t)lr * 1024 + col), s);
                        float xv[8]; unpack8(*(const u32x4*)((const bf16_t*)(ws + WS_XB) + (size_t)lr * 1024 + col), xv);
                        float* yr = (lr < GROWS ? out + O_YP + ((size_t)g * GROWS + lr) * DM : out + O_YS + (size_t)(lr - GROWS) * DM) + col;
                        *(f32x4*)yr = (f32x4){xv[0] + s[0] * a[0], xv[1] + s[1] * a[1], xv[2] + s[2] * a[2], xv[3] + s[3] * a[3]};
                        *(f32x4*)(yr + 4) = (f32x4){xv[4] + s[4] * a[4], xv[5] + s[5] * a[5], xv[6] + s[6] * a[6], xv[7] + s[7] * a[7]};
                    }
                }
                if (mode == M_OUT || mode == M_DOWN) {
                    rss += __shfl_xor(rss, 16); rss += __shfl_xor(rss, 32);
                    if (fq == 0) ((float*)(ws + WS_SSX))[(size_t)lr * 16 + u.pn * 4 + wc] = rss;
                }
            }
    }
};

__device__ __forceinline__ void run_gemm(LAS unsigned char* lds, const Params& P, int mode, int g, const bf16_t* A, const bf16_t* Bt, int M, int N, int K, int wv) {
    pg8::Gemm gm{A, Bt, M, N, K}; pg8::StaticOrder S; S.init(M, N, (int)gridDim.x, lbid());
    if (mode == M_IN) {
        LAS float* ev = (LAS float*)(lds + 131072); const int t_ = ltid_w(wv);
        for (int i = t_; i < 2304; i += 512) ev[i] = i < 64 ? P.in[I_GQ][i] : (i < 128 ? P.in[I_GK][i - 64] : (i < 160 ? P.in[I_DTB][i - 128] : (i < 256 ? 0.f : P.in[I_BGATE][i - 256])));
        __syncthreads();
    }
    int rsb_ = -1;
    if (mode == M_PB || mode == M_UP || mode == M_PG) {
        pg8::Unit u0; const bool has_ = S.next(0, u0);
        if (has_) {
            rsb_ = (u0.pm >> 3) << 3;
            LAS float* rt = (LAS float*)(lds + 131072); const int t_ = ltid_w(wv); const unsigned char* ws_ = lws(P);
            for (int r = t_; r < 2048; r += 512) {
                const int lr = rsb_ * 256 + r; float s = 0.f;
                if (lr < M) {
                    if (mode == M_PB) { const f32x4* sp = (const f32x4*)((const float*)(ws_ + WS_SSQ) + (size_t)lr * 32);
#pragma unroll
                        for (int q4 = 0; q4 < 8; ++q4) { const f32x4 x = sp[q4]; s += (x[0] + x[1]) + (x[2] + x[3]); }
                        s = rsqrtf(s * (1.f / 2048.f) + EPS);
                    } else { const f32x4* sp = (const f32x4*)((const float*)(ws_ + WS_SSX) + (size_t)lr * 16);
#pragma unroll
                        for (int q4 = 0; q4 < 4; ++q4) { const f32x4 x = sp[q4]; s += (x[0] + x[1]) + (x[2] + x[3]); }
                        s = rsqrtf(s * (1.f / 1024.f) + EPS);
                    }
                }
                rt[r] = s;
            }
        }
        __syncthreads();
    }
    Epi E{P.in[I_XP], P.in[I_XS], P.in[I_GQ], P.in[I_GK], P.in[I_BGATE], P.in[I_DTB], P.out, lws(P), mode, g, (const LAS float*)(lds + 131072), rsb_};
    pg8::gemm_phase<Epi, pg8::StaticOrder, true, true>(lds, gm, S, E, ltid_w(wv));
    __syncthreads();
}

__device__ __forceinline__ void tr_item(const float* W, int ldsrc, int srccol0, int k0, bf16_t* WT, size_t dstrow0, int ldd, const float* kscale, LAS float* scr, int lane) {
#pragma unroll
    for (int i = 0; i < 8; ++i) { const int kk = 8 * i + (lane >> 3), c4 = (lane & 7) * 4; f32x4 v = (f32x4){0.f, 0.f, 0.f, 0.f};
        if (srccol0 >= 0) { v = *(const f32x4*)(W + (size_t)(k0 + kk) * ldsrc + srccol0 + c4); if (kscale) v = v * kscale[k0 + kk]; }
        scr[kk * 33 + c4] = v[0]; scr[kk * 33 + c4 + 1] = v[1]; scr[kk * 33 + c4 + 2] = v[2]; scr[kk * 33 + c4 + 3] = v[3]; }
    asm volatile("s_waitcnt lgkmcnt(0)" ::: "memory");
    const int c = lane & 7;
#pragma unroll
    for (int j = 0; j < 4; ++j) { const int n = (lane >> 3) + 8 * j; const LAS float* s = scr + (8 * c) * 33 + n;
        u32x4 o; o.x = pk2(s[0 * 33], s[1 * 33]); o.y = pk2(s[2 * 33], s[3 * 33]); o.z = pk2(s[4 * 33], s[5 * 33]); o.w = pk2(s[6 * 33], s[7 * 33]);
        *(u32x4*)(WT + (dstrow0 + n) * (size_t)ldd + k0 + 8 * c) = o; }
    asm volatile("s_waitcnt lgkmcnt(0)" ::: "memory");
}
__device__ __forceinline__ int win_srccol(int n0) {
    const int tile = n0 >> 8, tc = n0 & 255;
    if (tile < 8) { const int bj = tc >> 7, wc = (tc & 127) >> 5; return (tile < 4 ? 0 : 1024) + (4 * (tile & 3) + wc) * 64 + 32 * bj; }
    if (tile < 12) return 2048 + (tile - 8) * 256 + tc;
    if (tile < 20) return 3072 + (tile - 12) * 256 + tc;
    if (tile < 32) return 5120 + (tile - 20) * 256 + tc;
    if (tile < 40) return 8224 + (tile - 32) * 256 + tc;
    return tc < 32 ? 8192 + tc : -1;
}
__device__ __forceinline__ void tr_matrix(const float* W, int K, int ldsrc, int Ndst, bool winmap, bf16_t* WT, int ldd, const float* kscale, LAS float* scr, int gw, int NGW, int lane) {
    const int nblk = Ndst / 32, nit = (K / 64) * nblk;
    for (int it = gw; it < nit; it += NGW) { const int kb = it / nblk, nb = it % nblk; tr_item(W, ldsrc, winmap ? win_srccol(nb * 32) : nb * 32, kb * 64, WT, (size_t)nb * 32, ldd, kscale, scr, lane); }
}
__device__ __forceinline__ void prologue(const Params& P, LAS unsigned char* lds, int wv) {
    const int tid = ltid_w(wv), lane = tid & 63, wave = tid >> 6;
    LAS float* scr = (LAS float*)(lds + wave * 16384);
    const int gw = lbid() * 8 + wave, NGW = gridDim.x * 8;
    unsigned char* ws = lws(P);
    tr_matrix(P.in[I_WIN], 1024, NIN, NINP, true, (bf16_t*)(ws + WS_W1T), 1024, nullptr, scr, gw, NGW, lane);
    tr_matrix(P.in[I_WUP], 1024, 6144, 6144, false, (bf16_t*)(ws + WS_WUT), 1024, P.in[I_GFFN], scr, gw, NGW, lane);
    tr_matrix(P.in[I_WDOWN], 3072, 1024, 1024, false, (bf16_t*)(ws + WS_WDT), 3072, nullptr, scr, gw, NGW, lane);
    tr_matrix(P.in[I_WPB], 2048, 1024, 1024, false, (bf16_t*)(ws + WS_WBT), 2048, P.in[I_GSSM], scr, gw, NGW, lane);
    tr_matrix(P.in[I_WPA], 1024, 1024, 1024, false, (bf16_t*)(ws + WS_WAT), 1024, nullptr, scr, gw, NGW, lane);
    tr_matrix(P.in[I_WOUT], 1024, 1024, 1024, false, (bf16_t*)(ws + WS_WOT), 1024, nullptr, scr, gw, NGW, lane);
    tr_matrix(P.in[I_WPG], 1024, 1024, 1024, false, (bf16_t*)(ws + WS_WGT), 1024, P.in[I_GPLE], scr, gw, NGW, lane);
    tr_matrix(P.in[I_WPLE], 256, 1024, 1024, false, (bf16_t*)(ws + WS_WPT), 256, nullptr, scr, gw, NGW, lane);
    const size_t gt = (size_t)lbid() * 512 + tid, GT = (size_t)gridDim.x * 512;
    for (size_t i = gt; i < (size_t)8 * 512 * 128; i += GT) {
        const size_t b = i / (512 * 128), t = (i / 128) % 512, c8 = i % 128, head = c8 >> 3, d8 = c8 & 7;
        const f32x4 a = *(const f32x4*)(P.in[I_CK] + i * 8), c = *(const f32x4*)(P.in[I_CK] + i * 8 + 4);
        u32x4 w; w.x = pk2(a[0], a[1]); w.y = pk2(a[2], a[3]); w.z = pk2(c[0], c[1]); w.w = pk2(c[2], c[3]);
        *(u32x4*)((bf16_t*)(ws + WS_KS) + (b * 16 + head) * 576 * 64 + (t >> 4) * 1024 + (d8 >> 2) * 512 + (d8 & 3) * 128 + (t & 15) * 8) = w;
    }
    for (size_t i = gt; i < (size_t)8 * 16 * 256; i += GT) { const size_t bh = i / 256, rem = i % 256; *(u32x4*)((bf16_t*)(ws + WS_KS) + bh * 576 * 64 + (size_t)34 * 1024 + rem * 8) = (u32x4){0, 0, 0, 0}; }
    for (size_t i = gt; i < (size_t)8 * 128 * 128; i += GT) {
        const size_t b = i / (128 * 128), tg = (i / 128) % 128, c8 = i % 128;
        float v[4][8];
#pragma unroll
        for (int k = 0; k < 4; ++k) { const float* sp = P.in[I_CV] + ((b * 512 + tg * 4 + k) * 1024 + c8 * 8); const f32x4 a = *(const f32x4*)sp, c = *(const f32x4*)(sp + 4); v[k][0] = a[0]; v[k][1] = a[1]; v[k][2] = a[2]; v[k][3] = a[3]; v[k][4] = c[0]; v[k][5] = c[1]; v[k][6] = c[2]; v[k][7] = c[3]; }
        bf16_t* dp = (bf16_t*)(ws + WS_VTS) + b * 576 * 1024 + (tg * 1024 + c8 * 8) * 4;
#pragma unroll
        for (int e = 0; e < 8; e += 2) { u32x4 w; w.x = pk2(v[0][e], v[1][e]); w.y = pk2(v[2][e], v[3][e]); w.z = pk2(v[0][e + 1], v[1][e + 1]); w.w = pk2(v[2][e + 1], v[3][e + 1]); *(u32x4*)(dp + e * 4) = w; }
    }
    for (size_t i = gt; i < (size_t)8 * 8 * 512; i += GT) { const size_t b = i / (8 * 512), rem = i % (8 * 512); *(u32x4*)((bf16_t*)(ws + WS_VTS) + b * 576 * 1024 + (size_t)136 * 4096 + rem * 8) = (u32x4){0, 0, 0, 0}; }
}

__device__ __forceinline__ void norm_pass(const Params& P, int g, int wv) {
    const int tid = ltid_w(wv), lane = tid & 63, wave = tid >> 6;
    const int gw = lbid() * 8 + wave, NGW = gridDim.x * 8, nr = grows(g);
    const float* gvec = P.in[I_GMIX];
    f32x4 gv[4];
#pragma unroll
    for (int j = 0; j < 4; ++j) gv[j] = *(const f32x4*)(gvec + 4 * lane + 256 * j);
    unsigned char* ws = lws(P);
    bf16_t* dst = (bf16_t*)(ws + (g == 0 ? WS_H : WS_H1)); bf16_t* ped = (bf16_t*)(ws + (g == 0 ? WS_PE : WS_PE1));
    for (int lr = gw; lr < nr; lr += NGW) {
        const float* src = xrow(P, g, lr);
        f32x4 v[4]; float s = 0.f;
#pragma unroll
        for (int j = 0; j < 4; ++j) { v[j] = *(const f32x4*)(src + 4 * lane + 256 * j); s += v[j][0] * v[j][0] + v[j][1] * v[j][1] + v[j][2] * v[j][2] + v[j][3] * v[j][3]; }
        const float rs = rsqrtf(wave_sum(s) * (1.f / 1024.f) + EPS);
#pragma unroll
        for (int j = 0; j < 4; ++j) { u32x2 w; w.x = pk2(v[j][0] * rs * gv[j][0], v[j][1] * rs * gv[j][1]); w.y = pk2(v[j][2] * rs * gv[j][2], v[j][3] * rs * gv[j][3]); *(u32x2*)(dst + (size_t)lr * 1024 + 4 * lane + 256 * j) = w; }
        const float* pr = lr < GROWS ? P.in[I_PP] + ((size_t)g * GROWS + lr) * PLE : P.in[I_PS] + (size_t)(lr - GROWS) * PLE;
        const f32x4 pv = *(const f32x4*)(pr + 4 * lane); u32x2 w; w.x = pk2(pv[0], pv[1]); w.y = pk2(pv[2], pv[3]);
        *(u32x2*)(ped + (size_t)lr * PLE + 4 * lane) = w;
    }
}

__device__ __forceinline__ bf16_t* bcc_row(const Params& P, int g, int lr) {
    return lr < GROWS ? (bf16_t*)(P.out + O_YP + (size_t)g * GROWS * DM) + (size_t)lr * 1024 : (bf16_t*)(P.out + O_YS) + (size_t)(lr - GROWS) * 1024;
}
__device__ __forceinline__ void bc_prepass(const Params& P, int g, int wv) {
    const size_t gt = (size_t)lbid() * 512 + ltid_w(wv), GT = (size_t)gridDim.x * 512;
    unsigned char* ws = lws(P);
    const bf16_t* xbc = (const bf16_t*)(ws + WS_XBC);
    const size_t n = (size_t)(grows(g) / 8) * 128;
    for (size_t i = gt; i < n; i += GT) {
        const int rg = (int)(i / 128), c0 = (int)(i % 128) * 8, lr0 = rg * 8, ch = 2048 + c0;
        int t0, sb = 0; const bool smp = lr0 >= GROWS; if (smp) { sb = (lr0 - GROWS) >> 5; t0 = (lr0 - GROWS) & 31; } else t0 = lr0 & 2047;
        float w[5][8];
#pragma unroll
        for (int k = 0; k < 5; ++k) { const float* wp = (k < 4 ? P.in[I_CSW] + k * 3072 : P.in[I_CSB]) + ch; const f32x4 a = *(const f32x4*)wp, b2 = *(const f32x4*)(wp + 4);
            w[k][0] = a[0]; w[k][1] = a[1]; w[k][2] = a[2]; w[k][3] = a[3]; w[k][4] = b2[0]; w[k][5] = b2[1]; w[k][6] = b2[2]; w[k][7] = b2[3]; }
        float pa[8], pb[8], pc[8];
#pragma unroll
        for (int k = 0; k < 3; ++k) {
            float* dst = k == 0 ? pa : (k == 1 ? pb : pc);
            if (t0 > 0) unpack8(*(const u32x4*)(xbc + (size_t)(lr0 - 3 + k) * 3072 + ch), dst);
            else if (smp) { const float* cp = P.in[I_CSSM] + ((size_t)sb * 3 + k) * 3072 + ch; const f32x4 a = *(const f32x4*)cp, b2 = *(const f32x4*)(cp + 4); dst[0] = a[0]; dst[1] = a[1]; dst[2] = a[2]; dst[3] = a[3]; dst[4] = b2[0]; dst[5] = b2[1]; dst[6] = b2[2]; dst[7] = b2[3]; }
            else {
#pragma unroll
                for (int e = 0; e < 8; ++e) dst[e] = 0.f;
            }
        }
#pragma unroll
        for (int r = 0; r < 8; ++r) {
            float cur[8], o[8];
            unpack8(*(const u32x4*)(xbc + (size_t)(lr0 + r) * 3072 + ch), cur);
#pragma unroll
            for (int e = 0; e < 8; ++e) { o[e] = siluf_(w[4][e] + w[0][e] * pa[e] + w[1][e] * pb[e] + w[2][e] * pc[e] + w[3][e] * cur[e]); pa[e] = pb[e]; pb[e] = pc[e]; pc[e] = cur[e]; }
            *(u32x4*)(bcc_row(P, g, lr0 + r) + c0) = pack8(o);
        }
    }
}

#define MFMA16(a, b, c) __builtin_amdgcn_mfma_f32_16x16x32_bf16((a), (b), (c), 0, 0, 0)
#define VMWAIT0() asm volatile("s_waitcnt vmcnt(0)" ::: "memory")
constexpr int SSD_RAW = 105728, SSD_ZS = 148608;
__device__ __forceinline__ int ssd_chmap(int c0, int h, int grp) { return c0 < 64 ? h * 64 + c0 : (c0 < 192 ? 2048 + grp * 128 + (c0 - 64) : 2560 + grp * 128 + (c0 - 192)); }
__device__ __forceinline__ void ssd_item(const Params& P, LAS unsigned char* lds, int g, int item, int wv) {
    const int tid = ltid_w(wv), lane = tid & 63, wave = __builtin_amdgcn_readfirstlane(tid >> 6), fr = lane & 15, fq = lane >> 4;
    unsigned char* ws = lws(P);
    const bool smp = item >= 256;
    const int sq = smp ? (item - 256) >> 5 : item >> 5, h = item & 31, grp = h >> 3;
    const int lr0 = smp ? GROWS + sq * 32 : sq * 2048, L = smp ? 32 : 64, nch = smp ? 1 : 32;
    LAS bf16_t* Xt = (LAS bf16_t*)(lds);
    LAS bf16_t* Xwt = (LAS bf16_t*)(lds + 9216);
    LAS bf16_t* Bm = (LAS bf16_t*)(lds + 18432);
    LAS bf16_t* Bt = (LAS bf16_t*)(lds + 35840);
    LAS bf16_t* Cm = (LAS bf16_t*)(lds + 54272);
    LAS bf16_t* Gm = (LAS bf16_t*)(lds + 71680);
    LAS bf16_t* Hb = (LAS bf16_t*)(lds + 80896);
    LAS float* sacs = (LAS float*)(lds + 104704);
    LAS float* sdt = sacs + 64;
    LAS float* sred = sacs + 128;
    LAS unsigned char* rawb = lds + SSD_RAW;
    LAS bf16_t* Zs = (LAS bf16_t*)(lds + SSD_ZS);
    const float aneg = -__expf(P.in[I_ALOG][h]), dskip = P.in[I_DSKIP][h];
    const bf16_t* xbc = (const bf16_t*)(ws + WS_XBC);
    const float* dtp = (const float*)(ws + WS_DT);
    bf16_t* zb = (bf16_t*)(ws + WS_Z);
    float* ssq = (float*)(ws + WS_SSQ);
    LAS float* cw = (LAS float*)(lds + 98304);
    for (int i = tid; i < 5 * 64; i += 512) { const int k = i >> 6, cc = i & 63; cw[i] = k < 4 ? P.in[I_CSW][k * 3072 + h * 64 + cc] : P.in[I_CSB][h * 64 + cc]; }
    const bf16_t* bcc0 = bcc_row(P, g, 0);
    const int pbH = wave >> 1, nbH0 = 4 * (wave & 1);
    f32x4 Hacc[4];
#pragma unroll
    for (int tt = 0; tt < 4; ++tt) {
        Hacc[tt] = (f32x4){0.f, 0.f, 0.f, 0.f};
        if (smp) Hacc[tt] = *(const f32x4*)(P.in[I_SSM] + (((size_t)sq * 32 + h) * 64 + pbH * 16 + fr) * 128 + (nbH0 + tt) * 16 + 4 * fq);
        u32x2 w; w.x = pk2(Hacc[tt][0], Hacc[tt][1]); w.y = pk2(Hacc[tt][2], Hacc[tt][3]);
        *(LAS u32x2*)(Hb + (pbH * 16 + fr) * 136 + (nbH0 + tt) * 16 + 4 * fq) = w;
    }
#define SSD_RAW_DMA(cc) do { const int tokc0_ = lr0 + (cc) * L; _Pragma("unroll") for (int k_ = 0; k_ < 6; ++k_) { const int sb_ = (k_ * 8 + wave) * 64; if (sb_ < 2747) { const int s_ = sb_ + lane, row_ = s_ / 41, o_ = s_ - row_ * 41; \
        const bool ok_ = (s_ < 2747) && (o_ < 40) && ((cc) > 0 || row_ >= 3) && (row_ - 3 < L) && (o_ < 8 || row_ >= 3); \
        const int lrr_ = tokc0_ - 3 + row_; \
        const bf16_t* src_ = o_ < 8 ? xbc + (size_t)lrr_ * 3072 + h * 64 + o_ * 8 : (smp ? bcc_s : bcc0) + (size_t)(smp ? lrr_ - GROWS : lrr_) * 1024 + (o_ < 24 ? grp * 128 + (o_ - 8) * 8 : 512 + grp * 128 + (o_ - 24) * 8); \
        if (ok_) __builtin_amdgcn_global_load_lds((const unsigned*)src_, (LAS unsigned*)(rawb + sb_ * 16), 16, 0, 0); } } } while (0)
    const bf16_t* bcc_s = bcc_row(P, g, GROWS);
    SSD_RAW_DMA(0);
    if (tid < 120) {
        const int row = tid / 40, o = tid - row * 40; u32x4 w = (u32x4){0u, 0u, 0u, 0u};
        if (smp && o < 8) { const float* cp = P.in[I_CSSM] + ((size_t)sq * 3 + row) * 3072 + h * 64 + o * 8; const f32x4 a = *(const f32x4*)cp, b2 = *(const f32x4*)(cp + 4); float v[8] = {a[0], a[1], a[2], a[3], b2[0], b2[1], b2[2], b2[3]}; w = pack8(v); }
        *(LAS u32x4*)(rawb + (row * 41 + o) * 16) = w;
    }
    float dtn = lane < L ? dtp[(size_t)(lr0 + lane) * 32 + h] : 0.f;
    VMWAIT0(); __syncthreads();
    for (int c = 0; c < nch; ++c) {
        const int tok0 = lr0 + c * L;
        u32x2 zreg[2];
        { const int i_ = (wave >> 1) * 16 + fr;
#pragma unroll
          for (int tt = 0; tt < 2; ++tt) { zreg[tt] = (u32x2){0u, 0u}; if (i_ < L) zreg[tt] = *(const u32x2*)(zb + (size_t)(tok0 + i_) * 2048 + h * 64 + (2 * (wave & 1) + tt) * 16 + 4 * fq); } }
        const float dtl = dtn;
        if (c + 1 < nch) dtn = dtp[(size_t)(tok0 + L + lane) * 32 + h];
        float acs = dtl * aneg;
#pragma unroll
        for (int o = 1; o < 64; o <<= 1) { const float t = __shfl_up(acs, o); if (lane >= o) acs += t; }
        const float last = __shfl(acs, 63);
        if (wave == 0) { sacs[lane] = acs; sdt[lane] = dtl; if (c > 0 && lane < L) ssq[(size_t)(tok0 - L + lane) * 32 + h] = sred[lane] + sred[64 + lane]; }
        {
            const int j = lane, xo = wave, c0 = xo * 8;
            float v[8];
#pragma unroll
            for (int e = 0; e < 8; ++e) v[e] = cw[256 + c0 + e];
#pragma unroll
            for (int i = 0; i < 4; ++i) { float r[8]; unpack8(*(const LAS u32x4*)(rawb + ((j + i) * 41 + xo) * 16), r);
#pragma unroll
                for (int e = 0; e < 8; ++e) v[e] += cw[i * 64 + c0 + e] * r[e]; }
            const float wj = __expf(last - acs) * dtl;
#pragma unroll
            for (int e = 0; e < 8; ++e) { const float x = j < L ? siluf_(v[e]) : 0.f; Xt[(c0 + e) * 72 + j] = (bf16_t)(pk2(x, 0.f) & 0xffffu); Xwt[(c0 + e) * 72 + j] = (bf16_t)(pk2(x * wj, 0.f) & 0xffffu); }
#pragma unroll
            for (int k = 0; k < 4; ++k) {
                const int jj = lane, o2 = wave + 8 * k;
                u32x4 w = (u32x4){0u, 0u, 0u, 0u};
                if (jj < L) w = *(const LAS u32x4*)(rawb + ((jj + 3) * 41 + 8 + o2) * 16);
                if (o2 < 16) {
                    *(LAS u32x4*)(Bm + jj * 136 + o2 * 8) = w;
                    LAS bf16_t* bt = Bt + (o2 * 8) * 72 + jj;
                    bt[0 * 72] = (bf16_t)(w.x & 0xffffu); bt[1 * 72] = (bf16_t)(w.x >> 16); bt[2 * 72] = (bf16_t)(w.y & 0xffffu); bt[3 * 72] = (bf16_t)(w.y >> 16);
                    bt[4 * 72] = (bf16_t)(w.z & 0xffffu); bt[5 * 72] = (bf16_t)(w.z >> 16); bt[6 * 72] = (bf16_t)(w.w & 0xffffu); bt[7 * 72] = (bf16_t)(w.w >> 16);
                } else {
                    *(LAS u32x4*)(Cm + jj * 136 + (o2 - 16) * 8) = w;
                }
            }
        }
        asm volatile("s_waitcnt lgkmcnt(0)" ::: "memory"); __builtin_amdgcn_s_barrier(); asm volatile("" ::: "memory");
        if (c + 1 < nch) SSD_RAW_DMA(c + 1);
        const int ib = wave >> 1;
        const float acsi = sacs[ib * 16 + fr];
        f32x4 yin[2];
#pragma unroll
        for (int tt = 0; tt < 2; ++tt) {
            const int jb = 2 * (wave & 1) + tt;
            f32x4 cbv = (f32x4){0.f, 0.f, 0.f, 0.f};
            if (jb <= ib) {
#pragma unroll
                for (int ks = 0; ks < 4; ++ks) {
                    const bf16x8 a = *(const LAS bf16x8*)(Bm + (jb * 16 + fr) * 136 + ks * 32 + fq * 8);
                    const bf16x8 b2 = *(const LAS bf16x8*)(Cm + (ib * 16 + fr) * 136 + ks * 32 + fq * 8);
                    cbv = MFMA16(a, b2, cbv);
                }
                const int i = ib * 16 + fr;
#pragma unroll
                for (int e = 0; e < 4; ++e) { const int j = jb * 16 + 4 * fq + e; cbv[e] = (j <= i) ? cbv[e] * __expf(acsi - sacs[j]) * sdt[j] : 0.f; }
            }
            u32x2 w; w.x = pk2(cbv[0], cbv[1]); w.y = pk2(cbv[2], cbv[3]);
            *(LAS u32x2*)(Gm + (ib * 16 + fr) * 72 + jb * 16 + 4 * fq) = w;
            const int pb = jb;
            f32x4 y = (f32x4){0.f, 0.f, 0.f, 0.f};
#pragma unroll
            for (int ks = 0; ks < 4; ++ks) {
                const bf16x8 a = *(const LAS bf16x8*)(Hb + (pb * 16 + fr) * 136 + ks * 32 + fq * 8);
                const bf16x8 b2 = *(const LAS bf16x8*)(Cm + (ib * 16 + fr) * 136 + ks * 32 + fq * 8);
                y = MFMA16(a, b2, y);
            }
            yin[tt] = y;
        }
        asm volatile("s_waitcnt lgkmcnt(0)" ::: "memory"); __builtin_amdgcn_s_barrier(); asm volatile("" ::: "memory");
        {
            const int i = ib * 16 + fr; const float eai = __expf(acsi); float ss = 0.f;
#pragma unroll
            for (int tt = 0; tt < 2; ++tt) {
                const int pb = 2 * (wave & 1) + tt;
                f32x4 y = (f32x4){0.f, 0.f, 0.f, 0.f};
#pragma unroll
                for (int ks = 0; ks < 2; ++ks) {
                    const bf16x8 a = *(const LAS bf16x8*)(Xt + (pb * 16 + fr) * 72 + ks * 32 + fq * 8);
                    const bf16x8 b2 = *(const LAS bf16x8*)(Gm + (ib * 16 + fr) * 72 + ks * 32 + fq * 8);
                    y = MFMA16(a, b2, y);
                }
                if (i < L) {
                    const u32x2 zw = zreg[tt];
                    const float sz[4] = {siluf_(bflo(zw.x)), siluf_(bfhi(zw.x)), siluf_(bflo(zw.y)), siluf_(bfhi(zw.y))};
                    float o[4];
#pragma unroll
                    for (int e = 0; e < 4; ++e) { const float xs = bf2f(Xt[(pb * 16 + 4 * fq + e) * 72 + i]); o[e] = (y[e] + eai * yin[tt][e] + dskip * xs) * sz[e]; ss += o[e] * o[e]; }
                    u32x2 w; w.x = pk2(o[0], o[1]); w.y = pk2(o[2], o[3]);
                    *(u32x2*)(zb + (size_t)(tok0 + i) * 2048 + h * 64 + pb * 16 + 4 * fq) = w;
                }
            }
            ss += __shfl_xor(ss, 16); ss += __shfl_xor(ss, 32);
            if (fq == 0) sred[(wave & 1) * 64 + i] = ss;
        }
        {
            const float el = __expf(last);
#pragma unroll
            for (int tt = 0; tt < 4; ++tt) {
                Hacc[tt] = Hacc[tt] * el;
#pragma unroll
                for (int ks = 0; ks < 2; ++ks) {
                    const bf16x8 a = *(const LAS bf16x8*)(Bt + ((nbH0 + tt) * 16 + fr) * 72 + ks * 32 + fq * 8);
                    const bf16x8 b2 = *(const LAS bf16x8*)(Xwt + (pbH * 16 + fr) * 72 + ks * 32 + fq * 8);
                    Hacc[tt] = MFMA16(a, b2, Hacc[tt]);
                }
            }
        }
#pragma unroll
        for (int tt = 0; tt < 4; ++tt) { u32x2 w; w.x = pk2(Hacc[tt][0], Hacc[tt][1]); w.y = pk2(Hacc[tt][2], Hacc[tt][3]); *(LAS u32x2*)(Hb + (pbH * 16 + fr) * 136 + (nbH0 + tt) * 16 + 4 * fq) = w; }
        if (smp) { asm volatile("s_waitcnt vmcnt(0) lgkmcnt(0)" ::: "memory"); } else { asm volatile("s_waitcnt vmcnt(2) lgkmcnt(0)" ::: "memory"); }
        __builtin_amdgcn_s_barrier(); asm volatile("" ::: "memory");
    }
    VMWAIT0(); __syncthreads();
    if (wave == 0 && lane < L) ssq[(size_t)(lr0 + (nch - 1) * L + lane) * 32 + h] = sred[lane] + sred[64 + lane];
    float* so = smp ? P.out + O_SSMS + (((size_t)sq * 32 + h) * 64) * 128 : P.out + O_SSMP + ((((size_t)g * 8 + sq) * 32 + h) * 64) * 128;
#pragma unroll
    for (int tt = 0; tt < 4; ++tt) *(f32x4*)(so + (size_t)(pbH * 16 + fr) * 128 + (nbH0 + tt) * 16 + 4 * fq) = Hacc[tt];
}

__device__ __forceinline__ void attn_wave(bf16_t* qo, const bf16_t* Kh, const bf16_t* Vth, int VP, int qpos0, int kstart, int seq_len, int t_lo, const LAS float* tbl, int lane) {
    const int fr = lane & 15, fq = lane >> 4;
    bf16x8 qf[2][2];
#pragma unroll
    for (int qb = 0; qb < 2; ++qb)
#pragma unroll
        for (int ks = 0; ks < 2; ++ks) qf[qb][ks] = *(const bf16x8*)(qo + (size_t)(qb * 16 + fr) * 1024 + ks * 32 + fq * 8);
    f32x4 o[2][4];
#pragma unroll
    for (int qb = 0; qb < 2; ++qb)
#pragma unroll
        for (int d = 0; d < 4; ++d) o[qb][d] = (f32x4){0.f, 0.f, 0.f, 0.f};
    float mrun[2] = {-1e30f, -1e30f}, lsum[2] = {0.f, 0.f};
    bf16x8 kc[4][2];
    {
        const int kt0 = kstart + 64 * t_lo;
#pragma unroll
        for (int blk = 0; blk < 4; ++blk) { const bf16_t* kp = Kh + (size_t)((kt0 >> 4) + blk) * 1024 + fq * 128 + fr * 8; kc[blk][0] = *(const bf16x8*)kp; kc[blk][1] = *(const bf16x8*)(kp + 512); }
    }
    const float bc = tbl[256];
    s16x4 vlo[4][2], vhi[4][2];
    {
        const int kt0 = kstart + 64 * t_lo;
#pragma unroll
        for (int d = 0; d < 4; ++d)
#pragma unroll
            for (int ks = 0; ks < 2; ++ks) { const bf16_t* vp = Vth + ((size_t)((kt0 + 32 * ks + 4 * fq) >> 2) * 1024 + d * 16 + fr) * 4; vlo[d][ks] = *(const s16x4*)vp; vhi[d][ks] = *(const s16x4*)(vp + 4 * 1024 * 4); }
    }
    for (int t = t_lo; t < 9; ++t) {
        const int kt0 = kstart + 64 * t, kt1 = kstart + 64 * (t < 8 ? t + 1 : t);
        s16x4 vnl[4][2], vnh[4][2];
#pragma unroll
        for (int d = 0; d < 4; ++d)
#pragma unroll
            for (int ks = 0; ks < 2; ++ks) { const bf16_t* vp = Vth + ((size_t)((kt1 + 32 * ks + 4 * fq) >> 2) * 1024 + d * 16 + fr) * 4; vnl[d][ks] = *(const s16x4*)vp; vnh[d][ks] = *(const s16x4*)(vp + 4 * 1024 * 4); }
        bf16x8 kn[4][2];
#pragma unroll
        for (int blk = 0; blk < 4; ++blk) { const bf16_t* kp = Kh + (size_t)((kt1 >> 4) + blk) * 1024 + fq * 128 + fr * 8; kn[blk][0] = *(const bf16x8*)kp; kn[blk][1] = *(const bf16x8*)(kp + 512); }
        f32x4 s[2][4];
#pragma unroll
        for (int qb = 0; qb < 2; ++qb)
#pragma unroll
            for (int blk = 0; blk < 4; ++blk) { f32x4 z = (f32x4){0.f, 0.f, 0.f, 0.f}; z = MFMA16(kc[blk][0], qf[qb][0], z); s[qb][blk] = MFMA16(kc[blk][1], qf[qb][1], z); }
        const bool cst = (qpos0 - (kt0 + 63)) >= 128;
        const bool tail = (kt0 + 64) > seq_len;
        bf16x8 pbv[2][2];
#pragma unroll
        for (int qb = 0; qb < 2; ++qb) {
            const int qpos = qpos0 + qb * 16 + fr;
            float mx = -1e30f, cc;
            if (cst && !tail) {
#pragma unroll
                for (int blk = 0; blk < 4; ++blk) mx = fmaxf(fmaxf(mx, fmaxf(s[qb][blk][0], s[qb][blk][1])), fmaxf(s[qb][blk][2], s[qb][blk][3]));
                mx += bc; cc = bc;
            } else {
#pragma unroll
                for (int blk = 0; blk < 4; ++blk)
#pragma unroll
                    for (int e = 0; e < 4; ++e) {
                        const int kpos = kt0 + blk * 16 + 4 * fq + e;
                        int rel = qpos - kpos; rel = rel < -128 ? -128 : (rel > 128 ? 128 : rel);
                        float v = s[qb][blk][e] + tbl[rel + 128];
                        if (tail && kpos >= seq_len) v = -1e30f;
                        s[qb][blk][e] = v; mx = fmaxf(mx, v);
                    }
                cc = 0.f;
            }
            mx = fmaxf(mx, __shfl_xor(mx, 16)); mx = fmaxf(mx, __shfl_xor(mx, 32));
            const float mnew = fmaxf(mrun[qb], mx), sc = __builtin_amdgcn_exp2f(mrun[qb] - mnew);
            mrun[qb] = mnew; cc -= mnew;
            float ps = 0.f;
#pragma unroll
            for (int blk = 0; blk < 4; ++blk)
#pragma unroll
                for (int e = 0; e < 4; ++e) { const float p = __builtin_amdgcn_exp2f(s[qb][blk][e] + cc); s[qb][blk][e] = p; ps += p; }
            lsum[qb] = lsum[qb] * sc + ps;
            if (__any(sc != 1.f)) {
#pragma unroll
                for (int d = 0; d < 4; ++d) o[qb][d] = o[qb][d] * sc;
            }
#pragma unroll
            for (int ks = 0; ks < 2; ++ks) {
                u32x4 pw; pw.x = pk2(s[qb][2 * ks][0], s[qb][2 * ks][1]); pw.y = pk2(s[qb][2 * ks][2], s[qb][2 * ks][3]); pw.z = pk2(s[qb][2 * ks + 1][0], s[qb][2 * ks + 1][1]); pw.w = pk2(s[qb][2 * ks + 1][2], s[qb][2 * ks + 1][3]);
                pbv[qb][ks] = __builtin_bit_cast(bf16x8, pw);
            }
        }
#pragma unroll
        for (int ks = 0; ks < 2; ++ks)
#pragma unroll
            for (int d = 0; d < 4; ++d) {
                const bf16x8 a = (bf16x8){vlo[d][ks][0], vlo[d][ks][1], vlo[d][ks][2], vlo[d][ks][3], vhi[d][ks][0], vhi[d][ks][1], vhi[d][ks][2], vhi[d][ks][3]};
                o[0][d] = MFMA16(a, pbv[0][ks], o[0][d]); o[1][d] = MFMA16(a, pbv[1][ks], o[1][d]);
            }
#pragma unroll
        for (int blk = 0; blk < 4; ++blk) { kc[blk][0] = kn[blk][0]; kc[blk][1] = kn[blk][1]; }
#pragma unroll
        for (int d = 0; d < 4; ++d)
#pragma unroll
            for (int ks = 0; ks < 2; ++ks) { vlo[d][ks] = vnl[d][ks]; vhi[d][ks] = vnh[d][ks]; }
    }
#pragma unroll
    for (int qb = 0; qb < 2; ++qb) {
        float l = lsum[qb]; l += __shfl_xor(l, 16); l += __shfl_xor(l, 32);
        const float inv = 1.f / l;
#pragma unroll
        for (int d = 0; d < 4; ++d) { u32x2 w; w.x = pk2(o[qb][d][0] * inv, o[qb][d][1] * inv); w.y = pk2(o[qb][d][2] * inv, o[qb][d][3] * inv); *(u32x2*)(qo + (size_t)(qb * 16 + fr) * 1024 + d * 16 + 4 * fq) = w; }
    }
}

__device__ __forceinline__ void mixer_phase(const Params& P, LAS unsigned char* lds, int g, int wv) {
    const int tid = ltid_w(wv), lane = tid & 63, wave = __builtin_amdgcn_readfirstlane(tid >> 6);
    unsigned char* ws = lws(P);
    const int nssd = g == 0 ? 256 : 512;
    for (int it = lbid(); it < nssd; it += gridDim.x) { ssd_item(P, lds, g, it, wv); __syncthreads(); }
    LAS float* tbl = (LAS float*)lds;
    for (int i = tid; i < 16 * 257; i += 512) tbl[i] = P.in[I_REL][i] * LOG2E;
    __syncthreads();
    bf16_t* q = (bf16_t*)(ws + WS_Q);
    const int nblk = 8 * 32 * 4 + (g == 1 ? 16 : 0);
    const int abx_ = lbid(), aG_ = (int)gridDim.x, avcu = (aG_ % 8 == 0) ? (abx_ % 8) * (aG_ / 8) + abx_ / 8 : abx_;
    for (int bu = avcu; bu < nblk; bu += aG_) {
        if (bu < 1024) {
            const int bl = bu >> 7, c = (bu >> 2) & 31, h = (bu & 3) * 4 + (wave >> 1), half = wave & 1;
            const int qpos0 = c * 64 + half * 32;
            attn_wave(q + ((size_t)bl * 2048 + qpos0) * 1024 + h * 64, (const bf16_t*)(ws + WS_K) + ((size_t)bl * 16 + h) * 2048 * 64,
                      (const bf16_t*)(ws + WS_VT) + (size_t)bl * 2048 * 1024 + h * 64 * 4, 2048, qpos0, c * 64 - 512, 2048, c < 8 ? 8 - c : 0, tbl + h * 257, lane);
        } else {
            const int wi = (bu - 1024) * 8 + wave, sb = wi >> 4, h = wi & 15;
            attn_wave(q + ((size_t)GROWS + sb * 32) * 1024 + h * 64, (const bf16_t*)(ws + WS_KS) + ((size_t)sb * 16 + h) * 576 * 64,
                      (const bf16_t*)(ws + WS_VTS) + (size_t)sb * 576 * 1024 + h * 64 * 4, 576, 512, 0, 544, 0, tbl + h * 257, lane);
        }
    }
}

__device__ __forceinline__ void sg_kloop(f32x4 (&acc)[4], const bf16_t* A, const bf16_t* Bt, int K, int row0, int col0, int wave, int fr, int fq) {
    const int ksub = K >> 3, k0 = wave * ksub;
    const bf16_t* ap = A + (size_t)(row0 + fr) * K + k0 + fq * 8;
    const bf16_t* bp = Bt + (size_t)(col0 + fr) * K + k0 + fq * 8;
    if (ksub >= 128) {
        for (int kk = 0; kk < ksub; kk += 128) {
            bf16x8 a[4], bq[4][4];
#pragma unroll
            for (int s = 0; s < 4; ++s) { a[s] = *(const bf16x8*)(ap + kk + 32 * s);
#pragma unroll
                for (int t = 0; t < 4; ++t) bq[s][t] = *(const bf16x8*)(bp + (size_t)(16 * t) * K + kk + 32 * s); }
#pragma unroll
            for (int s = 0; s < 4; ++s)
#pragma unroll
                for (int t = 0; t < 4; ++t) acc[t] = MFMA16(bq[s][t], a[s], acc[t]);
        }
    } else {
        for (int kk = 0; kk < ksub; kk += 32) {
            const bf16x8 a = *(const bf16x8*)(ap + kk);
#pragma unroll
            for (int t = 0; t < 4; ++t) { const bf16x8 bq = *(const bf16x8*)(bp + (size_t)(16 * t) * K + kk); acc[t] = MFMA16(bq, a, acc[t]); }
        }
    }
}
__device__ __forceinline__ void sg_reduce(f32x4 (&acc)[4], LAS float* red, int wave, int lane) {
    if (wave > 0) {
#pragma unroll
        for (int t = 0; t < 4; ++t)
#pragma unroll
            for (int e = 0; e < 4; ++e) red[((wave - 1) * 16 + t * 4 + e) * 64 + lane] = acc[t][e];
    }
    __syncthreads();
    if (wave == 0) {
#pragma unroll
        for (int w = 0; w < 7; ++w)
#pragma unroll
            for (int t = 0; t < 4; ++t)
#pragma unroll
                for (int e = 0; e < 4; ++e) acc[t][e] += red[(w * 16 + t * 4 + e) * 64 + lane];
    }
    __syncthreads();
}
enum { SM_AB = 0, SM_OUT, SM_UP, SM_DOWN, SM_PLE };
__device__ __forceinline__ void sample_stage(const Params& P, LAS unsigned char* lds, int mode, int wv) {
    const int tid = ltid_w(wv), lane = tid & 63, wave = __builtin_amdgcn_readfirstlane(tid >> 6), fr = lane & 15, fq = lane >> 4;
    unsigned char* ws = lws(P);
    LAS float* red = (LAS float*)lds;
    const int ncb = mode == SM_UP ? 96 : 16, ntask = 16 * ncb;
    for (int task = lbid(); task < ntask; task += gridDim.x) {
        const int rb = task / ncb, cb = task - rb * ncb, row0 = rb * 16, col0 = cb * 64;
        f32x4 acc[4], acc2[4];
#pragma unroll
        for (int t = 0; t < 4; ++t) { acc[t] = (f32x4){0.f, 0.f, 0.f, 0.f}; acc2[t] = (f32x4){0.f, 0.f, 0.f, 0.f}; }
        if (mode == SM_AB) {
            sg_kloop(acc, (const bf16_t*)(ws + WS_Q) + (size_t)GROWS * 1024, (const bf16_t*)(ws + WS_WAT), 1024, row0, col0, wave, fr, fq);
            sg_kloop(acc2, (const bf16_t*)(ws + WS_Z) + (size_t)GROWS * 2048, (const bf16_t*)(ws + WS_WBT), 2048, row0, col0, wave, fr, fq);
        } else if (mode == SM_OUT) {
            sg_kloop(acc, (const bf16_t*)(ws + WS_H) + (size_t)GROWS * 1024, (const bf16_t*)(ws + WS_WOT), 1024, row0, col0, wave, fr, fq);
        } else if (mode == SM_UP) {
            sg_kloop(acc, (const bf16_t*)(ws + WS_XB) + (size_t)GROWS * 1024, (const bf16_t*)(ws + WS_WUT), 1024, row0, col0, wave, fr, fq);
        } else if (mode == SM_DOWN) {
            sg_kloop(acc, (const bf16_t*)(ws + WS_GA) + (size_t)GROWS * 3072, (const bf16_t*)(ws + WS_WDT), 3072, row0, col0, wave, fr, fq);
        } else {
            sg_kloop(acc, (const bf16_t*)(ws + WS_XB) + (size_t)GROWS * 1024, (const bf16_t*)(ws + WS_WGT), 1024, row0, col0, wave, fr, fq);
            sg_kloop(acc2, (const bf16_t*)(ws + WS_PE1) + (size_t)GROWS * 256, (const bf16_t*)(ws + WS_WPT), 256, row0, col0, wave, fr, fq);
        }
        sg_reduce(acc, red, wave, lane);
        if (mode == SM_AB || mode == SM_PLE) sg_reduce(acc2, red, wave, lane);
        if (wave == 0) {
            const int r = row0 + fr, lr = GROWS + r;
            float rs = 1.f;
            if (mode == SM_AB) { const f32x4* sp = (const f32x4*)((const float*)(ws + WS_SSQ) + (size_t)lr * 32); float s = 0.f;
#pragma unroll
                for (int q4 = 0; q4 < 8; ++q4) { const f32x4 x = sp[q4]; s += (x[0] + x[1]) + (x[2] + x[3]); }
                rs = rsqrtf(s * (1.f / 2048.f) + EPS); }
            if (mode == SM_UP || mode == SM_PLE) { const f32x4* sp = (const f32x4*)((const float*)(ws + WS_SSX) + (size_t)lr * 16); float s = 0.f;
#pragma unroll
                for (int q4 = 0; q4 < 4; ++q4) { const f32x4 x = sp[q4]; s += (x[0] + x[1]) + (x[2] + x[3]); }
                rs = rsqrtf(s * (1.f / 1024.f) + EPS); }
            float ss = 0.f;
#pragma unroll
            for (int t = 0; t < 4; ++t) {
                const int c = col0 + 16 * t + 4 * fq;
                if (mode == SM_AB) {
                    const u32x2 ga = *(const u32x2*)((const bf16_t*)(ws + WS_GT) + (size_t)lr * 2048 + c), gb = *(const u32x2*)((const bf16_t*)(ws + WS_GT) + (size_t)lr * 2048 + 1024 + c);
                    const float g0[4] = {bflo(ga.x), bfhi(ga.x), bflo(ga.y), bfhi(ga.y)}, g1[4] = {bflo(gb.x), bfhi(gb.x), bflo(gb.y), bfhi(gb.y)};
                    float v[4];
#pragma unroll
                    for (int e = 0; e < 4; ++e) v[e] = bf2f((bf16_t)(pk2(g0[e] * acc[t][e], 0.f) & 0xffffu)) + g1[e] * rs * acc2[t][e];
                    u32x2 w; w.x = pk2(v[0], v[1]); w.y = pk2(v[2], v[3]);
                    *(u32x2*)((bf16_t*)(ws + WS_H) + (size_t)lr * 1024 + c) = w;
                } else if (mode == SM_OUT || mode == SM_DOWN) {
                    bf16_t* xbp = (bf16_t*)(ws + WS_XB) + (size_t)lr * 1024 + c;
                    f32x4 x;
                    if (mode == SM_OUT) x = *(const f32x4*)(P.in[I_XS] + (size_t)r * DM + c);
                    else { const u32x2 xw = *(const u32x2*)xbp; x = (f32x4){bflo(xw.x), bfhi(xw.x), bflo(xw.y), bfhi(xw.y)}; }
                    const f32x4 v = (f32x4){x[0] + acc[t][0], x[1] + acc[t][1], x[2] + acc[t][2], x[3] + acc[t][3]};
                    u32x2 w; w.x = pk2(v[0], v[1]); w.y = pk2(v[2], v[3]);
                    *(u32x2*)xbp = w;
                    ss += (v[0] * v[0] + v[1] * v[1]) + (v[2] * v[2] + v[3] * v[3]);
                } else if (mode == SM_UP) {
                    const f32x4 v = acc[t] * rs;
                    u32x2 w; w.x = pk2(v[0], v[1]); w.y = pk2(v[2], v[3]);
                    *(u32x2*)((bf16_t*)(ws + WS_U) + (size_t)lr * 6144 + c) = w;
                    const int bq = r >> 5, tq = r & 31;
                    if (tq >= 30) *(f32x4*)(P.out + O_CFS + ((size_t)bq * 2 + (tq - 30)) * 6144 + c) = v;
                } else {
                    float* yr = P.out + O_YS + (size_t)r * DM + c;
                    const u32x2 xw = *(const u32x2*)((const bf16_t*)(ws + WS_XB) + (size_t)lr * 1024 + c);
                    const f32x4 x = (f32x4){bflo(xw.x), bfhi(xw.x), bflo(xw.y), bfhi(xw.y)};
                    f32x4 v;
#pragma unroll
                    for (int e = 0; e < 4; ++e) v[e] = x[e] + bf2f((bf16_t)(pk2(sigmoidf_(acc[t][e] * rs), 0.f) & 0xffffu)) * acc2[t][e];
                    *(f32x4*)yr = v;
                }
            }
            if (mode == SM_OUT || mode == SM_DOWN) {
                ss += __shfl_xor(ss, 16); ss += __shfl_xor(ss, 32);
                if (fq == 0) {
                    ((float*)(ws + WS_SSX))[(size_t)lr * 16 + cb] = ss;
                }
            }
        }
    }
    asm volatile("s_waitcnt vmcnt(0)" ::: "memory"); __syncthreads();
}

__device__ __forceinline__ float gelu_tanh(float x) { const float u = 0.7978845608028654f * (x + 0.044715f * x * x * x); return x * __builtin_amdgcn_rcpf(1.f + __builtin_amdgcn_exp2f(-2.f * LOG2E * u)); }
__device__ __forceinline__ void ew_phase(const Params& P, int g, int wv) {
    const size_t gt = (size_t)lbid() * 512 + ltid_w(wv), GT = (size_t)gridDim.x * 512;
    unsigned char* ws = lws(P);
    const bf16_t* ub = (const bf16_t*)(ws + WS_U); bf16_t* ga = (bf16_t*)(ws + WS_GA);
    const size_t n = (size_t)(grows(g) / 8) * 384;
    for (size_t i = gt; i < n; i += GT) {
        const int rg = (int)(i / 384), c0 = (int)(i % 384) * 8, lr0 = rg * 8;
        int t0, sb = 0; const bool smp = lr0 >= GROWS; if (smp) { sb = (lr0 - GROWS) >> 5; t0 = (lr0 - GROWS) & 31; } else t0 = lr0 & 2047;
        float w[2][4][8];
#pragma unroll
        for (int hf = 0; hf < 2; ++hf)
#pragma unroll
            for (int k = 0; k < 4; ++k) { const float* wp = (k < 3 ? P.in[I_FCW] + k * 6144 : P.in[I_FCB]) + hf * 3072 + c0; const f32x4 a = *(const f32x4*)wp, b2 = *(const f32x4*)(wp + 4);
                w[hf][k][0] = a[0]; w[hf][k][1] = a[1]; w[hf][k][2] = a[2]; w[hf][k][3] = a[3]; w[hf][k][4] = b2[0]; w[hf][k][5] = b2[1]; w[hf][k][6] = b2[2]; w[hf][k][7] = b2[3]; }
        float pa[2][8], pb[2][8];
#pragma unroll
        for (int hf = 0; hf < 2; ++hf) {
            const int ch = hf * 3072 + c0;
#pragma unroll
            for (int k = 0; k < 2; ++k) {
                float* dst = k == 0 ? pa[hf] : pb[hf];
                if (t0 > 0) unpack8(*(const u32x4*)(ub + (size_t)(lr0 - 2 + k) * 6144 + ch), dst);
                else if (smp) { const float* cp = P.in[I_CFFN] + ((size_t)sb * 2 + k) * 6144 + ch; const f32x4 a = *(const f32x4*)cp, b2 = *(const f32x4*)(cp + 4); dst[0] = a[0]; dst[1] = a[1]; dst[2] = a[2]; dst[3] = a[3]; dst[4] = b2[0]; dst[5] = b2[1]; dst[6] = b2[2]; dst[7] = b2[3]; }
                else {
#pragma unroll
                    for (int e = 0; e < 8; ++e) dst[e] = 0.f;
                }
            }
        }
#pragma unroll
        for (int r = 0; r < 8; ++r) {
            float cur[2][8], res[2][8];
#pragma unroll
            for (int hf = 0; hf < 2; ++hf) {
                unpack8(*(const u32x4*)(ub + (size_t)(lr0 + r) * 6144 + hf * 3072 + c0), cur[hf]);
#pragma unroll
                for (int e = 0; e < 8; ++e) { res[hf][e] = w[hf][3][e] + w[hf][0][e] * pa[hf][e] + w[hf][1][e] * pb[hf][e] + w[hf][2][e] * cur[hf][e]; pa[hf][e] = pb[hf][e]; pb[hf][e] = cur[hf][e]; }
            }
            float o[8];
#pragma unroll
            for (int e = 0; e < 8; ++e) o[e] = gelu_tanh(res[0][e]) * res[1][e];
            *(u32x4*)(ga + (size_t)(lr0 + r) * 3072 + c0) = pack8(o);
        }
    }
}

#define XB_TMO      128
#define XB_XCNT(j)  (256  + 64 * (j))
#define XB_XSUB(j)  (1280 + 64 * (j))
#define XB_XGEN(j)  (2304 + 64 * (j))
#define XB_TOP      3328
#define XB_TOPGEN   3392
#define XCD_BAR_WORDS 3456
#define XB_SPIN_CAP (1u << 18)

__device__ __forceinline__ unsigned xb_ld(unsigned* p)              { return __hip_atomic_load(p, __ATOMIC_RELAXED, __HIP_MEMORY_SCOPE_AGENT); }
__device__ __forceinline__ unsigned xb_add(unsigned* p, unsigned v) { return __hip_atomic_fetch_add(p, v, __ATOMIC_RELAXED, __HIP_MEMORY_SCOPE_AGENT); }
__device__ __forceinline__ unsigned xb_xcc_id() { return (unsigned)__builtin_amdgcn_s_getreg((3 << 11) | 20) & 0xFu; }
#define XB_SPIN(cond, bar) do { unsigned _sp = 0; while (cond) { __builtin_amdgcn_s_sleep(1); \
    if ((++_sp & 255u) == 0u) { if (xb_ld(&(bar)[XB_TMO])) break; if (_sp > XB_SPIN_CAP) { atomicAdd(&(bar)[XB_TMO], 1u); break; } } } } while (0)

struct XcdBarrier {
    unsigned* bar; unsigned x;
    volatile LAS unsigned* st;
};

__device__ __forceinline__ XcdBarrier xcd_barrier_post(unsigned* bar, volatile LAS unsigned* st, int tid_) {
    XcdBarrier b; b.bar = bar; b.x = xb_xcc_id(); b.st = st;
    if (tid_ == 0) (void)xb_add(&bar[XB_XCNT(b.x)], 1u);
    return b;
}
__device__ __forceinline__ void xcd_barrier_complete(unsigned* bar, unsigned x, unsigned& nloc, unsigned& nx) {
    const unsigned G = gridDim.x * gridDim.y * gridDim.z;
    unsigned sum, cnt, mine, sp = 0u;
    for (;;) {
        sum = 0u; cnt = 0u; mine = 0u;
#pragma unroll
        for (unsigned j = 0; j < 16; ++j) { const unsigned c = xb_ld(&bar[XB_XCNT(j)]); sum += c; cnt += (c > 0u) ? 1u : 0u; mine = (j == x) ? c : mine; }
        if (sum == G) break;
        __builtin_amdgcn_s_sleep(1);
        if ((++sp & 255u) == 0u) { if (xb_ld(&bar[XB_TMO])) break; if (sp > XB_SPIN_CAP) { atomicAdd(&bar[XB_TMO], 1u); break; } }
    }
    nloc = mine > 0u ? mine : 1u; nx = cnt > 0u ? cnt : 1u;
}

__device__ __forceinline__ void xcd_barrier(const XcdBarrier& b, int tid_) {
    asm volatile("s_waitcnt vmcnt(0)" ::: "memory");
    __syncthreads();
    if (tid_ == 0) {
        unsigned* bar = b.bar;
        __builtin_amdgcn_s_waitcnt(0);
        unsigned nloc = b.st[0], nx = b.st[1];
        if (nloc == 0u) { xcd_barrier_complete(bar, b.x, nloc, nx); b.st[0] = nloc; b.st[1] = nx; }
        const unsigned old = xb_add(&bar[XB_XSUB(b.x)], 1u);
        const unsigned gen = old / nloc;
        if (old + 1u == (gen + 1u) * nloc) {
            __builtin_amdgcn_fence(__ATOMIC_RELEASE, "agent");
            asm volatile("s_waitcnt vmcnt(0)" ::: "memory");
            const unsigned og = xb_add(&bar[XB_TOP], 1u);
            const unsigned tg = og / nx;
            if (og + 1u == (tg + 1u) * nx) xb_add(&bar[XB_TOPGEN], 1u);
            else XB_SPIN(xb_ld(&bar[XB_TOPGEN]) == tg, bar);
            __builtin_amdgcn_fence(__ATOMIC_ACQUIRE, "agent");
            xb_add(&bar[XB_XGEN(b.x)], 1u);
            asm volatile("s_waitcnt vmcnt(0)" ::: "memory");
        } else {
            XB_SPIN(xb_ld(&bar[XB_XGEN(b.x)]) == gen, bar);
            __builtin_amdgcn_fence(__ATOMIC_ACQUIRE, "agent");
            asm volatile("s_waitcnt vmcnt(0)" ::: "memory");
        }
    }
    __syncthreads();
}


constexpr int NPHASE = 19;
__device__ __forceinline__ void gbar(unsigned* ctr, unsigned target, int tid) {
    asm volatile("s_waitcnt vmcnt(0)" ::: "memory");
    __syncthreads();
    if (tid == 0) {
        __builtin_amdgcn_fence(__ATOMIC_RELEASE, "agent");
        asm volatile("s_waitcnt vmcnt(0)" ::: "memory");
        __hip_atomic_fetch_add(ctr, 1u, __ATOMIC_RELAXED, __HIP_MEMORY_SCOPE_AGENT);
        while (__hip_atomic_load(ctr, __ATOMIC_RELAXED, __HIP_MEMORY_SCOPE_AGENT) < target) __builtin_amdgcn_s_sleep(1);
        __builtin_amdgcn_fence(__ATOMIC_ACQUIRE, "agent");
        asm volatile("s_waitcnt vmcnt(0)" ::: "memory");
    }
    __syncthreads();
}
#define PH_IN(k) (P.ph_lo <= (k) && (k) < P.ph_hi)
#define PH_SYNC(k) do { if (PH_IN(k) && PH_IN((k) + 1)) { xcd_barrier(xbar, ltid_w(wv)); } } while (0)
#define WSB(off) ((const bf16_t*)(lws(P) + (off)))
#define GROUP_PHASES(g, base, M) \
    if (PH_IN(base + 0)) run_gemm(lds, P, M_IN, g, WSB(g == 0 ? WS_H : WS_H1), WSB(WS_W1T), M, NINP, 1024, wv); PH_SYNC(base + 0); \
    if (PH_IN(base + 1)) bc_prepass(P, g, wv); PH_SYNC(base + 1); \
    if (PH_IN(base + 2)) mixer_phase(P, lds, g, wv); PH_SYNC(base + 2); \
    if (PH_IN(base + 3)) { if (g == 1) sample_stage(P, lds, SM_AB, wv); run_gemm(lds, P, M_PA, g, WSB(WS_Q), WSB(WS_WAT), GROWS, 1024, 1024, wv); run_gemm(lds, P, M_PB, g, WSB(WS_Z), WSB(WS_WBT), GROWS, 1024, 2048, wv); } PH_SYNC(base + 3); \
    if (PH_IN(base + 4)) { if (g == 1) sample_stage(P, lds, SM_OUT, wv); run_gemm(lds, P, M_OUT, g, WSB(WS_H), WSB(WS_WOT), GROWS, 1024, 1024, wv); } PH_SYNC(base + 4); \
    if (PH_IN(base + 5)) { if (g == 1) sample_stage(P, lds, SM_UP, wv); run_gemm(lds, P, M_UP, g, WSB(WS_XB), WSB(WS_WUT), GROWS, 6144, 1024, wv); } PH_SYNC(base + 5); \
    if (PH_IN(base + 6)) ew_phase(P, g, wv); PH_SYNC(base + 6); \
    if (PH_IN(base + 7)) { if (g == 1) sample_stage(P, lds, SM_DOWN, wv); run_gemm(lds, P, M_DOWN, g, WSB(WS_GA), WSB(WS_WDT), GROWS, 1024, 3072, wv); } PH_SYNC(base + 7); \
    if (PH_IN(base + 8)) { if (g == 1) sample_stage(P, lds, SM_PLE, wv); run_gemm(lds, P, M_PG, g, WSB(WS_XB), WSB(WS_WGT), GROWS, 1024, 1024, wv); run_gemm(lds, P, M_PLE, g, WSB(g == 0 ? WS_PE : WS_PE1), WSB(WS_WPT), GROWS, 1024, 256, wv); }
__global__ void __launch_bounds__(512, 2) fwd_kernel(Params P) {
    extern __shared__ __attribute__((aligned(16))) unsigned char lds_raw[];
    LAS unsigned char* lds = (LAS unsigned char*)lds_raw;
    cg::grid_group grid = cg::this_grid();
    int wv = __builtin_amdgcn_readfirstlane(threadIdx.x >> 6); asm volatile("" : "+s"(wv));
    if (P.ph_hi - P.ph_lo > 1) grid.sync();
    volatile LAS unsigned* xst = (volatile LAS unsigned*)(lds + 157184);
    { const int t0_ = ltid_w(wv); if (t0_ < 2) xst[t0_] = 0u; __syncthreads(); }
    XcdBarrier xbar = xcd_barrier_post((unsigned*)(lws(P) + 1024), xst, ltid_w(wv));
    if (PH_IN(0)) { prologue(P, lds, wv); norm_pass(P, 0, wv); norm_pass(P, 1, wv); }
    PH_SYNC(0);
    GROUP_PHASES(0, 1, GROWS)
    PH_SYNC(9);
    GROUP_PHASES(1, 10, TMAX)
}

#ifndef MULTI_LAUNCH
#define MULTI_LAUNCH 0
#endif
#ifdef DBG_SRC
__global__ void dbg_dump(const unsigned short* src, float* dst, size_t n) { for (size_t i = (size_t)blockIdx.x * blockDim.x + threadIdx.x; i < n; i += (size_t)gridDim.x * blockDim.x) dst[i] = bf2f(src[i]); }
#endif
extern "C" void kernel_launch(void* const* d_in, const int* in_sizes, int n_in, void* d_out, int out_size, void* d_ws, size_t ws_size, hipStream_t stream) {
    static int grid = 0;
    if (grid == 0) {
        if (n_in != 32 || ws_size < WS_END) { fprintf(stderr, "kernel_launch: unexpected n_in %d / ws_size %zu (need %zu)\n", n_in, ws_size, (size_t)WS_END); grid = -1; return; }
        int dev = 0, cus = 0, per_cu = 0;
        hipGetDevice(&dev); hipDeviceGetAttribute(&cus, hipDeviceAttributeMultiprocessorCount, dev);
        if (hipFuncSetAttribute((const void*)fwd_kernel, hipFuncAttributeMaxDynamicSharedMemorySize, LDS_BYTES) != hipSuccess) { fprintf(stderr, "hipFuncSetAttribute failed\n"); grid = -1; return; }
        if (hipOccupancyMaxActiveBlocksPerMultiprocessor(&per_cu, (const void*)fwd_kernel, 512, LDS_BYTES) != hipSuccess || per_cu < 1) { fprintf(stderr, "occupancy query: %d\n", per_cu); per_cu = 1; }
        (void)hipGetLastError();
        grid = cus * per_cu;
    }
    if (grid < 0) return;
    Params p{};
    for (int i = 0; i < 32; ++i) p.in[i] = (const float*)d_in[i];
    p.out = (float*)d_out; p.ws = (unsigned char*)d_ws;
#if MULTI_LAUNCH
#ifndef DBG_HI
#define DBG_HI NPHASE
#endif
    for (int ph = 0; ph < DBG_HI; ++ph) { p.ph_lo = ph; p.ph_hi = ph + 1; hipLaunchKernelGGL(fwd_kernel, dim3(grid), dim3(512), LDS_BYTES, stream, p); }
#ifdef DBG_SRC
    hipLaunchKernelGGL(dbg_dump, dim3(2048), dim3(256), 0, stream, (const unsigned short*)((unsigned char*)d_ws + (DBG_SRC)), (float*)d_out, (size_t)(DBG_N));
#endif
#else
    p.ph_lo = 0; p.ph_hi = NPHASE;
    (void)hipMemsetAsync(d_ws, 0, 16384, stream);
    void* args[] = {&p};
    hipError_t e = hipLaunchCooperativeKernel((const void*)fwd_kernel, dim3(grid), dim3(512), args, LDS_BYTES, stream);
    if (e != hipSuccess) fprintf(stderr, "cooperative launch failed: %s (grid %d)\n", hipGetErrorString(e), grid);
#endif
}
```

```cpp
#include <hip/hip_runtime.h>
#include <hip/hip_cooperative_groups.h>
#include <cstdio>
#include <cstdint>
namespace cg = cooperative_groups;
namespace pg8 {
#define PG8_LAS __attribute__((address_space(3)))
typedef unsigned short bf16_t;
typedef short bf16x8 __attribute__((ext_vector_type(8)));
typedef float f32x4 __attribute__((ext_vector_type(4)));
typedef unsigned u32x4 __attribute__((ext_vector_type(4)));
constexpr int BM = 256, BK = 64, HALF = 128, HTB = HALF * BK * 2  , STAGE_BYTES = 8 * HTB, NXCD = 8, WGM = 8;

__host__ __device__ __forceinline__ int lds_byte(int r, int c) { const int st = (r >> 4) * 2 + (c >> 5), rr = r & 15, cc = c & 31, ob = rr * 64 + cc * 2; return st * 1024 + (ob ^ (((ob >> 9) & 1) << 5)); }
__host__ __device__ __forceinline__ void stage_rc(int b, int& R, int& C) { const int st = b / 1024, sb = b % 1024, swz = sb ^ (((sb >> 9) & 1) << 5); R = (st >> 1) * 16 + swz / 64; C = (st & 1) * 32 + (swz % 64) / 2; }
__host__ __device__ __forceinline__ int perm32(int rho) { const int n = rho >> 4, i = rho & 15; return 8 * (i >> 2) + 4 * n + (i & 3); }

struct Unit { int pm, pn; };
struct Gemm { const bf16_t* A; const bf16_t* Bt; int M, N, K; };

struct StaticOrder {
    int nM, nN, nwg, G, c;
    __host__ __device__ __forceinline__ void init(int M, int N, int G_, int c_) { nM = M / BM; nN = N / BM; nwg = nM * nN; G = G_; c = c_; }
    __host__ __device__ __forceinline__ bool next(int i, Unit& u) const {
        const long L = (long)i * G + c; if (L >= nwg) return false;
        int wgid = (int)L; { const int q = nwg / NXCD, r = nwg % NXCD, xcd = wgid % NXCD, off = wgid / NXCD; wgid = (xcd < r ? xcd * (q + 1) : r * (q + 1) + (xcd - r) * q) + off; }
        const int nig = WGM * nN, gid = wgid / nig, fm = gid * WGM, gsz = (nM - fm) < WGM ? (nM - fm) : WGM;
        u.pm = fm + ((wgid % nig) % gsz); u.pn = (wgid % nig) / gsz; return true;
    }
    __device__ __forceinline__ void a_ready(const Unit&) const {}
    __device__ __forceinline__ void done(const Unit&) const {}
};

__device__ __forceinline__ unsigned cvt_pk_bf16(float lo, float hi) { unsigned r; asm volatile("v_cvt_pk_bf16_f32 %0, %1, %2" : "=v"(r) : "v"(lo), "v"(hi)); return r; }
template <class Epi, class Sched, bool ALIGN_EPI = false, bool SP2 = false>
__device__ __forceinline__ void gemm_phase(PG8_LAS unsigned char* lds, const Gemm g, const Sched& S, const Epi& E, int tid_in) {
    int tid_l = tid_in; asm volatile("" : "+v"(tid_l)); const int tid = tid_l, wid = __builtin_amdgcn_readfirstlane(tid >> 6), lane = tid & 63, wr = wid >> 2, wc = wid & 3, fr = lane & 15, fq = lane >> 4;
    const int K = g.K, nt = K / BK;
    unsigned voffA[2], voffB[2];
#pragma unroll
    for (int i = 0; i < 2; ++i) { int R, C; stage_rc(tid * 16 + i * 8192, R, C); const int Rb = Epi::PERM ? ((R & ~31) + perm32(R & 31)) : R;
        voffA[i] = (unsigned)(R * K + C) * 2u; voffB[i] = (unsigned)(Rb * K + C) * 2u; }
    const size_t kstep = (size_t)(BK * 2);
    const size_t hstep = (size_t)HALF * K * 2;
    const size_t tstep = 2 * hstep;
    const unsigned ldsw = (unsigned)wid * 1024u;
    const int aoff = lds_byte(wr * 64 + fr, fq * 8), boff = lds_byte(wc * 32 + fr, fq * 8);
#define PG8_SA(b, h) (((b) * 2 + (h)) * HTB)
#define PG8_SB(b, h) ((4 + (b) * 2 + (h)) * HTB)
#define PG8_STAGE(bufoff, gbase, voff) do { _Pragma("unroll") for (int _i = 0; _i < 2; ++_i) \
        __builtin_amdgcn_global_load_lds((const unsigned*)((const char*)(gbase) + (voff)[_i]), (PG8_LAS unsigned*)(lds + (bufoff) + ldsw + _i * 8192), 16, 0, 0); } while (0)
#define PG8_LDA(dst, b, h) do { _Pragma("unroll") for (int m = 0; m < 4; ++m) _Pragma("unroll") for (int k = 0; k < 2; ++k) dst[m][k] = *(const PG8_LAS bf16x8*)(lds + PG8_SA(b, h) + aoff + m * 2048 + k * 1024); } while (0)
#define PG8_LDB(dst, b, h) do { _Pragma("unroll") for (int n = 0; n < 2; ++n) _Pragma("unroll") for (int k = 0; k < 2; ++k) dst[n][k] = *(const PG8_LAS bf16x8*)(lds + PG8_SB(b, h) + boff + n * 2048 + k * 1024); } while (0)
#define PG8_MMA(ai, bj, At, Bt) do { __builtin_amdgcn_s_setprio(1); _Pragma("unroll") for (int m = 0; m < 4; ++m) _Pragma("unroll") for (int n = 0; n < 2; ++n) _Pragma("unroll") for (int k = 0; k < 2; ++k) \
        acc[ai][bj][m][n] = __builtin_amdgcn_mfma_f32_16x16x32_bf16(Bt[n][k], At[m][k], acc[ai][bj][m][n], 0, 0, 0); __builtin_amdgcn_s_setprio(0); } while (0)
#define PG8_WAIT_V(n) asm volatile("s_waitcnt vmcnt(" #n ")" ::: "memory")
#define PG8_WAIT_L(n) asm volatile("s_waitcnt lgkmcnt(" #n ")" ::: "memory")
#define PG8_BAR __builtin_amdgcn_s_barrier()
#define PG8_SCHED __builtin_amdgcn_sched_barrier(0)
    Unit cur, nxt; int ui = 0;
    if (!S.next(0, cur)) return;
    f32x4 acc[2][2][4][2];
#pragma unroll
    for (int a = 0; a < 2; ++a)
#pragma unroll
        for (int b = 0; b < 2; ++b)
#pragma unroll
            for (int m = 0; m < 4; ++m)
#pragma unroll
                for (int n = 0; n < 2; ++n) acc[a][b][m][n] = (f32x4){0.f, 0.f, 0.f, 0.f};
    bf16x8 At[4][2], B0[2][2], B1[2][2];
    const char* cA = (const char*)g.A + (size_t)cur.pm * tstep; const char* cB = (const char*)g.Bt + (size_t)cur.pn * tstep;
    S.a_ready(cur);
    if constexpr (SP2) {
        PG8_STAGE(PG8_SB(0, 0), cB, voffB); PG8_STAGE(PG8_SB(0, 1), cB + hstep, voffB); PG8_STAGE(PG8_SA(0, 0), cA, voffA); PG8_STAGE(PG8_SA(0, 1), cA + hstep, voffA);
        if (wr == 1) PG8_BAR;
        PG8_WAIT_V(2); PG8_BAR;
        PG8_STAGE(PG8_SB(1, 0), cB + kstep, voffB); PG8_STAGE(PG8_SA(1, 0), cA + kstep, voffA); PG8_STAGE(PG8_SB(1, 1), cB + hstep + kstep, voffB);
        PG8_WAIT_V(6); PG8_BAR;
    } else {
        PG8_STAGE(PG8_SB(0, 0), cB, voffB); PG8_STAGE(PG8_SA(0, 0), cA, voffA); PG8_STAGE(PG8_SB(0, 1), cB + hstep, voffB); PG8_STAGE(PG8_SA(0, 1), cA + hstep, voffA);
        if (wr == 1) PG8_BAR;
        PG8_WAIT_V(4); PG8_BAR;
        PG8_STAGE(PG8_SB(1, 0), cB + kstep, voffB); PG8_STAGE(PG8_SA(1, 0), cA + kstep, voffA); PG8_STAGE(PG8_SB(1, 1), cB + hstep + kstep, voffB);
        PG8_WAIT_V(6); PG8_BAR;
    }
    for (;;) {
        const bool has_next = S.next(ui + 1, nxt);
        const char* nA = has_next ? (const char*)g.A + (size_t)nxt.pm * tstep : cA; const char* nB = has_next ? (const char*)g.Bt + (size_t)nxt.pn * tstep : cB;
        for (int t = 0; t < nt; t += 2) {
            const bool last = (t == nt - 2);
            const char* a1 = cA + (size_t)(t + 1) * kstep;
            const char* a2 = last ? nA : cA + (size_t)(t + 2) * kstep; const char* b2 = last ? nB : cB + (size_t)(t + 2) * kstep;
            const char* a3 = a2 + kstep; const char* b3 = b2 + kstep;
            if (last && has_next) S.a_ready(nxt);
            if constexpr (SP2) {
            PG8_LDB(B0, 0, 0); PG8_LDB(B1, 0, 1); PG8_SCHED; PG8_LDA(At, 0, 0); PG8_STAGE(PG8_SA(1, 1), a1 + hstep, voffA);
            PG8_WAIT_V(8); PG8_WAIT_L(0); PG8_BAR; PG8_MMA(0, 0, At, B0); PG8_MMA(0, 1, At, B1); PG8_BAR; PG8_SCHED;
            PG8_LDA(At, 0, 1); PG8_STAGE(PG8_SB(0, 0), b2, voffB); PG8_STAGE(PG8_SB(0, 1), b2 + hstep, voffB); PG8_STAGE(PG8_SA(0, 0), a2, voffA);
            PG8_WAIT_V(8); PG8_WAIT_L(0); PG8_BAR; PG8_MMA(1, 0, At, B0); PG8_MMA(1, 1, At, B1); PG8_BAR; PG8_SCHED;
            PG8_LDB(B0, 1, 0); PG8_LDB(B1, 1, 1); PG8_SCHED; PG8_LDA(At, 1, 0); PG8_STAGE(PG8_SA(0, 1), a2 + hstep, voffA);
            PG8_WAIT_V(8); PG8_WAIT_L(0); PG8_BAR; PG8_MMA(0, 0, At, B0); PG8_MMA(0, 1, At, B1); PG8_BAR; PG8_SCHED;
            PG8_LDA(At, 1, 1); PG8_STAGE(PG8_SB(1, 0), b3, voffB); PG8_STAGE(PG8_SB(1, 1), b3 + hstep, voffB); PG8_STAGE(PG8_SA(1, 0), a3, voffA);
            PG8_WAIT_V(8); PG8_WAIT_L(0); PG8_BAR; PG8_MMA(1, 0, At, B0); PG8_MMA(1, 1, At, B1); PG8_BAR; PG8_SCHED;
            } else {
            PG8_LDB(B0, 0, 0); PG8_SCHED; PG8_LDA(At, 0, 0); PG8_STAGE(PG8_SA(1, 1), a1 + hstep, voffA);
            PG8_WAIT_L(8); PG8_BAR; PG8_WAIT_L(0); PG8_MMA(0, 0, At, B0); PG8_BAR; PG8_SCHED;
            PG8_LDB(B1, 0, 1); PG8_STAGE(PG8_SB(0, 0), b2, voffB);
            PG8_BAR; PG8_WAIT_L(0); PG8_MMA(0, 1, At, B1); PG8_BAR;
            PG8_LDA(At, 0, 1); PG8_STAGE(PG8_SA(0, 0), a2, voffA);
            PG8_BAR; PG8_WAIT_L(0); PG8_MMA(1, 0, At, B0); PG8_BAR; PG8_SCHED;
            PG8_STAGE(PG8_SB(0, 1), b2 + hstep, voffB);
            PG8_WAIT_V(6); PG8_BAR; PG8_MMA(1, 1, At, B1); PG8_BAR;
            PG8_LDB(B0, 1, 0); PG8_SCHED; PG8_LDA(At, 1, 0); PG8_STAGE(PG8_SA(0, 1), a2 + hstep, voffA);
            PG8_WAIT_L(8); PG8_BAR; PG8_WAIT_L(0); PG8_MMA(0, 0, At, B0); PG8_BAR; PG8_SCHED;
            PG8_LDB(B1, 1, 1); PG8_STAGE(PG8_SB(1, 0), b3, voffB);
            PG8_BAR; PG8_WAIT_L(0); PG8_MMA(0, 1, At, B1); PG8_BAR;
            PG8_LDA(At, 1, 1); PG8_STAGE(PG8_SA(1, 0), a3, voffA);
            PG8_BAR; PG8_WAIT_L(0); PG8_MMA(1, 0, At, B0); PG8_BAR; PG8_SCHED;
            PG8_STAGE(PG8_SB(1, 1), b3 + hstep, voffB);
            PG8_WAIT_V(6); PG8_BAR; PG8_MMA(1, 1, At, B1); PG8_BAR;
            }
        }
        if constexpr (ALIGN_EPI) { if (wr == 0) PG8_BAR; }
        if constexpr (!Epi::AFTER_DRAIN) { E(acc, cur, wr, wc, fr, fq); S.done(cur); }
        if (!has_next) break;
#pragma unroll
        for (int a = 0; a < 2; ++a)
#pragma unroll
            for (int b = 0; b < 2; ++b)
#pragma unroll
                for (int m = 0; m < 4; ++m)
#pragma unroll
                    for (int n = 0; n < 2; ++n) acc[a][b][m][n] = (f32x4){0.f, 0.f, 0.f, 0.f};
        cur = nxt; cA = nA; cB = nB; ++ui;
        if constexpr (ALIGN_EPI) { if (wr == 1) PG8_BAR; }
    }
    PG8_WAIT_V(0);
    if constexpr (!ALIGN_EPI) { if (wr == 0) PG8_BAR; }
    PG8_BAR;
    if constexpr (Epi::AFTER_DRAIN) { E.fused(acc, cur, wr, wc, fr, fq, lds, wid, lane); S.done(cur); }
#undef PG8_SA
#undef PG8_SB
#undef PG8_STAGE
#undef PG8_LDA
#undef PG8_LDB
#undef PG8_MMA
#undef PG8_WAIT_V
#undef PG8_WAIT_L
#undef PG8_BAR
#undef PG8_SCHED
}
}

#define LAS __attribute__((address_space(3)))
typedef unsigned short bf16_t;
typedef short bf16x8 __attribute__((ext_vector_type(8)));
typedef short s16x4 __attribute__((ext_vector_type(4)));
typedef float f32x4 __attribute__((ext_vector_type(4)));
typedef unsigned u32x4 __attribute__((ext_vector_type(4)));
typedef unsigned u32x2 __attribute__((ext_vector_type(2)));

constexpr int DM = 1024, SEQ = 2048, NHA = 16, NHS = 32, CONVD = 3072, DFF = 3072, PLE = 256;
constexpr int NIN = 10272, NINP = 41 * 256;
constexpr int GROWS = 16384, TMAX = 16640;
constexpr float EPS = 1e-6f, LOG2E = 1.4426950408889634f, QSCALE = 0.125f * 1.4426950408889634f;

constexpr size_t O_YP = 0, O_YS = 33554432, O_KP = O_YS + 262144, O_VP = O_KP + 8388608, O_SSMP = O_VP + 8388608, O_CSP = O_SSMP + 4194304,
                 O_CFP = O_CSP + 147456, O_KS = O_CFP + 196608, O_VS = O_KS + 262144, O_SSMS = O_VS + 262144, O_CSS = O_SSMS + 2097152, O_CFS = O_CSS + 73728;

constexpr size_t al256(size_t x) { return (x + 255) & ~(size_t)255; }
constexpr size_t WS_W1T = 65536;
constexpr size_t WS_WAT = WS_W1T + (size_t)NINP * 1024 * 2;
constexpr size_t WS_WBT = WS_WAT + (size_t)1024 * 1024 * 2;
constexpr size_t WS_WOT = WS_WBT + (size_t)1024 * 2048 * 2;
constexpr size_t WS_WUT = WS_WOT + (size_t)1024 * 1024 * 2;
constexpr size_t WS_WDT = WS_WUT + (size_t)6144 * 1024 * 2;
constexpr size_t WS_WGT = WS_WDT + (size_t)1024 * 3072 * 2;
constexpr size_t WS_WPT = WS_WGT + (size_t)1024 * 1024 * 2;
constexpr size_t WS_KS  = WS_WPT + (size_t)1024 * 256 * 2;
constexpr size_t WS_VTS = WS_KS + (size_t)8 * 576 * 1024 * 2;
constexpr size_t WS_SSQ = WS_VTS + (size_t)8 * 576 * 1024 * 2;
constexpr size_t WS_SSX = WS_SSQ + al256((size_t)TMAX * 32 * 4);
constexpr size_t WS_H   = WS_SSX + al256((size_t)TMAX * 16 * 4);
constexpr size_t WS_Q   = WS_H + (size_t)TMAX * 1024 * 2;
constexpr size_t WS_K   = WS_Q + (size_t)TMAX * 1024 * 2;
constexpr size_t WS_VT  = WS_K + (size_t)TMAX * 1024 * 2;
constexpr size_t WS_Z   = WS_VT + (size_t)8 * 1024 * 2048 * 2;
constexpr size_t WS_XBC = WS_Z + (size_t)TMAX * 2048 * 2;
constexpr size_t WS_GT  = WS_XBC + (size_t)TMAX * 3072 * 2;
constexpr size_t WS_DT  = WS_GT + (size_t)TMAX * 2048 * 2;
constexpr size_t WS_PE  = WS_DT + (size_t)TMAX * 32 * 4;
constexpr size_t WS_PE1 = WS_PE + (size_t)TMAX * 256 * 2;
constexpr size_t WS_H1  = WS_PE1 + (size_t)TMAX * 256 * 2;
constexpr size_t WS_END = WS_H1 + (size_t)TMAX * 1024 * 2;
constexpr size_t WS_U   = WS_K;
constexpr size_t WS_GA  = WS_U + (size_t)TMAX * 6144 * 2;
constexpr size_t WS_ST  = WS_H;
constexpr size_t WS_XB  = WS_Q;
static_assert(WS_GA + (size_t)TMAX * 3072 * 2 <= WS_PE, "ffn overlay");
static_assert(WS_END <= (size_t)512 * 1024 * 1024, "ws budget");

constexpr int LDS_BYTES = 157696;

struct Params { const float* in[32]; float* out; unsigned char* ws; int ph_lo, ph_hi; };

enum { I_XP = 0, I_XS, I_CK, I_CV, I_SSM, I_CSSM, I_CFFN, I_PP, I_PS, I_GMIX, I_WIN, I_BGATE, I_GQ, I_GK, I_REL, I_CSW, I_CSB, I_DTB, I_ALOG, I_DSKIP, I_GSSM,
       I_WPA, I_WPB, I_WOUT, I_GFFN, I_WUP, I_FCW, I_FCB, I_WDOWN, I_GPLE, I_WPG, I_WPLE };

__device__ __forceinline__ int ltid_w(int wv) { int t = wv * 64 + (int)__builtin_amdgcn_mbcnt_hi(~0u, __builtin_amdgcn_mbcnt_lo(~0u, 0u)); asm volatile("" : "+v"(t)); return t; }
__device__ __forceinline__ int lbid() { int t = blockIdx.x; asm volatile("" : "+s"(t)); return t; }
__device__ __forceinline__ unsigned char* lws(const struct Params& P);
typedef float f32x2_t __attribute__((ext_vector_type(2))); typedef __bf16 bf16x2_t __attribute__((ext_vector_type(2)));
__device__ __forceinline__ unsigned pk2(float lo, float hi) { f32x2_t v = {lo, hi}; bf16x2_t r = __builtin_convertvector(v, bf16x2_t); return __builtin_bit_cast(unsigned, r); }
__device__ __forceinline__ float bf2f(unsigned short b) { return __uint_as_float(((unsigned)b) << 16); }
__device__ __forceinline__ float bflo(unsigned w) { return __uint_as_float(w << 16); }
__device__ __forceinline__ float bfhi(unsigned w) { return __uint_as_float(w & 0xffff0000u); }
__device__ __forceinline__ float sigmoidf_(float x) { return __builtin_amdgcn_rcpf(1.f + __builtin_amdgcn_exp2f(-LOG2E * x)); }
__device__ __forceinline__ float siluf_(float x) { return x * __builtin_amdgcn_rcpf(1.f + __builtin_amdgcn_exp2f(-LOG2E * x)); }
__device__ __forceinline__ float wave_sum(float v) {
#pragma unroll
    for (int o = 1; o < 64; o <<= 1) v += __shfl_xor(v, o);
    return v;
}
__device__ __forceinline__ u32x4 pack8(const float* v) { u32x4 w; w.x = pk2(v[0], v[1]); w.y = pk2(v[2], v[3]); w.z = pk2(v[4], v[5]); w.w = pk2(v[6], v[7]); return w; }
__device__ __forceinline__ void unpack8(u32x4 w, float* v) { v[0] = bflo(w.x); v[1] = bfhi(w.x); v[2] = bflo(w.y); v[3] = bfhi(w.y); v[4] = bflo(w.z); v[5] = bfhi(w.z); v[6] = bflo(w.w); v[7] = bfhi(w.w); }

__device__ __forceinline__ unsigned char* lws(const Params& P) { int z = 0; asm volatile("" : "+s"(z)); return P.ws + z; }
__device__ __forceinline__ const float* xrow(const Params& P, int g, int lr) { return lr < GROWS ? P.in[I_XP] + ((size_t)g * GROWS + lr) * DM : P.in[I_XS] + (size_t)(lr - GROWS) * DM; }
__device__ __forceinline__ float* yrow(const Params& P, int g, int lr) { return lr < GROWS ? P.out + O_YP + ((size_t)g * GROWS + lr) * DM : P.out + O_YS + (size_t)(lr - GROWS) * DM; }
__device__ __forceinline__ int grows(int g) { return g == 0 ? GROWS : TMAX; }

enum { M_IN = 0, M_PA, M_PB, M_OUT, M_UP, M_DOWN, M_PG, M_PLE };
struct Epi {
    static constexpr bool PERM = true, AFTER_DRAIN = false;
    const float *xp, *xs, *gq, *gk, *bgate, *dtb; float* out; unsigned char* wsb; int mode; int g; const LAS float* ev; int rsb;
    __device__ __forceinline__ void operator()(const f32x4 (&acc)[2][2][4][2], const pg8::Unit& u, int wr, int wc, int fr_, int fq_) const {
        int fr = fr_, fq = fq_; asm volatile("" : "+v"(fr), "+v"(fq));
        const int lane_ = fr + 16 * fq;
        unsigned char* ws = wsb;
        const int r0 = wr * 64 + fr;
        const int cb = wc * 32 + fq * 8;
        const bool smp = (u.pm == 64);
        if (mode == M_IN) {
            const int pn = u.pn;
            if (pn < 8) {
                const bool isk = pn >= 4; const int head = 4 * (pn & 3) + wc;
                const LAS float* gw = ev + (isk ? 64 : 0);
                float gv[2][8];
#pragma unroll
                for (int bj = 0; bj < 2; ++bj)
#pragma unroll
                    for (int e = 0; e < 8; ++e) gv[bj][e] = gw[32 * bj + 8 * fq + e];
#pragma unroll
                for (int ai = 0; ai < 2; ++ai)
#pragma unroll
                    for (int m = 0; m < 4; ++m) {
                        const int r = ai * 128 + m * 16 + r0; const int lr = u.pm * 256 + r;
                        float ss = 0.f;
#pragma unroll
                        for (int bj = 0; bj < 2; ++bj)
#pragma unroll
                            for (int n = 0; n < 2; ++n) { const f32x4 x = acc[ai][bj][m][n]; ss += x[0] * x[0] + x[1] * x[1] + x[2] * x[2] + x[3] * x[3]; }
                        ss += __shfl_xor(ss, 16); ss += __shfl_xor(ss, 32);
                        const float rs = rsqrtf(ss * (1.f / 64.f) + EPS);
                        int b, t; if (smp) { b = r >> 5; t = r & 31; } else { b = g * 8 + (u.pm >> 3); t = (u.pm & 7) * 256 + r; }
#pragma unroll
                        for (int bj = 0; bj < 2; ++bj) {
                            float v[8];
#pragma unroll
                            for (int e = 0; e < 8; ++e) v[e] = acc[ai][bj][m][e >> 2][e & 3] * rs * gv[bj][e];
                            const int col = head * 64 + 32 * bj + 8 * fq;
                            if (!isk) {
#pragma unroll
                                for (int e = 0; e < 8; ++e) v[e] *= QSCALE;
                                *(u32x4*)((bf16_t*)(ws + WS_Q) + (size_t)lr * 1024 + col) = pack8(v);
                            } else {
                                const int tk = smp ? 512 + t : t;
                                bf16_t* dst = (smp ? (bf16_t*)(ws + WS_KS) + ((size_t)b * 16 + head) * 576 * 64 : (bf16_t*)(ws + WS_K) + ((size_t)(u.pm >> 3) * 16 + head) * 2048 * 64)
                                              + (size_t)(tk >> 4) * 1024 + bj * 512 + fq * 128 + (tk & 15) * 8;
                                *(u32x4*)dst = pack8(v);
                                float* o = nullptr;
                                if (smp) o = out + O_KS + ((size_t)b * 32 + t) * 1024 + col; else if (t >= 1536) o = out + O_KP + ((size_t)b * 512 + (t - 1536)) * 1024 + col;
                                if (o) { *(f32x4*)o = (f32x4){v[0], v[1], v[2], v[3]}; *(f32x4*)(o + 4) = (f32x4){v[4], v[5], v[6], v[7]}; }
                            }
                        }
                    }
            } else if (pn < 12) {
#pragma unroll
                for (int ai = 0; ai < 2; ++ai)
#pragma unroll
                    for (int m = 0; m < 4; ++m) {
                        const int r = ai * 128 + m * 16 + r0;
                        int b, t; if (smp) { b = r >> 5; t = r & 31; } else { b = g * 8 + (u.pm >> 3); t = (u.pm & 7) * 256 + r; }
#pragma unroll
                        for (int bj = 0; bj < 2; ++bj) {
                            const int ch = (pn - 8) * 256 + bj * 128 + cb;
                            const int tt_ = smp ? 512 + t : t, j = fr & 3;
                            float v[8];
#pragma unroll
                            for (int e = 0; e < 8; ++e) v[e] = acc[ai][bj][m][e >> 2][e & 3];
                            const unsigned p0 = pk2(v[0], v[1]), p1 = pk2(v[2], v[3]), p2 = pk2(v[4], v[5]), p3 = pk2(v[6], v[7]);
                            unsigned got[4];
#pragma unroll
                            for (int r = 0; r < 4; ++r) { const int si = (j - r) & 3; const unsigned send = si == 0 ? p0 : (si == 1 ? p1 : (si == 2 ? p2 : p3)); got[r] = (unsigned)__shfl((int)send, (lane_ & ~3) | ((j + r) & 3)); }
                            unsigned tk[4];
#pragma unroll
                            for (int k = 0; k < 4; ++k) { const int gi = (k - j) & 3; tk[k] = gi == 0 ? got[0] : (gi == 1 ? got[1] : (gi == 2 ? got[2] : got[3])); }
                            u32x4 w; w.x = (tk[0] & 0xffffu) | (tk[1] << 16); w.y = (tk[2] & 0xffffu) | (tk[3] << 16); w.z = (tk[0] >> 16) | (tk[1] & 0xffff0000u); w.w = (tk[2] >> 16) | (tk[3] & 0xffff0000u);
                            *(u32x4*)((smp ? (bf16_t*)(ws + WS_VTS) + (size_t)b * 576 * 1024 : (bf16_t*)(ws + WS_VT) + (size_t)(u.pm >> 3) * 2048 * 1024) + ((size_t)((tt_ - j) >> 2) * 1024 + ch + 2 * j) * 4) = w;
                            float* o = nullptr;
                            if (smp) o = out + O_VS + ((size_t)b * 32 + t) * 1024 + ch; else if (t >= 1536) o = out + O_VP + ((size_t)b * 512 + (t - 1536)) * 1024 + ch;
                            if (o) { *(f32x4*)o = (f32x4){v[0], v[1], v[2], v[3]}; *(f32x4*)(o + 4) = (f32x4){v[4], v[5], v[6], v[7]}; }
                        }
                    }
            } else if (pn < 40) {
                const int kind = pn < 20 ? 0 : (pn < 32 ? 1 : 2);
                const int ct0 = (kind == 0 ? (pn - 12) : kind == 1 ? (pn - 20) : (pn - 32)) * 256;
                const int ld = kind == 1 ? 3072 : 2048;
                bf16_t* base = (bf16_t*)(ws + (kind == 0 ? WS_Z : kind == 1 ? WS_XBC : WS_GT));
                float bv[2][8];
#pragma unroll
                for (int bj = 0; bj < 2; ++bj)
#pragma unroll
                    for (int e = 0; e < 8; ++e) bv[bj][e] = kind == 2 ? ev[256 + ct0 + bj * 128 + cb + e] : 0.f;
#pragma unroll
                for (int ai = 0; ai < 2; ++ai)
#pragma unroll
                    for (int m = 0; m < 4; ++m) {
                        const int r = ai * 128 + m * 16 + r0; const int lr = u.pm * 256 + r;
                        int b, t, len; if (smp) { b = r >> 5; t = r & 31; len = 32; } else { b = g * 8 + (u.pm >> 3); t = (u.pm & 7) * 256 + r; len = 2048; }
#pragma unroll
                        for (int bj = 0; bj < 2; ++bj) {
                            const int col = ct0 + bj * 128 + cb;
                            float v[8];
#pragma unroll
                            for (int e = 0; e < 8; ++e) { float x = acc[ai][bj][m][e >> 2][e & 3]; v[e] = kind == 2 ? sigmoidf_(x + bv[bj][e]) : x; }
                            *(u32x4*)(base + (size_t)lr * ld + col) = pack8(v);
                            if (kind == 1 && t >= len - 3) {
                                float* o = smp ? out + O_CSS + ((size_t)b * 3 + (t - 29)) * 3072 + col : out + O_CSP + ((size_t)b * 3 + (t - 2045)) * 3072 + col;
                                *(f32x4*)o = (f32x4){v[0], v[1], v[2], v[3]}; *(f32x4*)(o + 4) = (f32x4){v[4], v[5], v[6], v[7]};
                            }
                        }
                    }
            } else {
                if (wc == 0) {
                    float db[8];
#pragma unroll
                    for (int e = 0; e < 8; ++e) db[e] = ev[128 + 8 * fq + e];
#pragma unroll
                    for (int ai = 0; ai < 2; ++ai)
#pragma unroll
                        for (int m = 0; m < 4; ++m) {
                            const int lr = u.pm * 256 + ai * 128 + m * 16 + r0;
                            float v[8];
#pragma unroll
                            for (int e = 0; e < 8; ++e) { const float x = acc[ai][0][m][e >> 2][e & 3] + db[e]; v[e] = x > 20.f ? x : log1pf(__expf(x)); }
                            float* o = (float*)(ws + WS_DT) + (size_t)lr * 32 + 8 * fq;
                            *(f32x4*)o = (f32x4){v[0], v[1], v[2], v[3]}; *(f32x4*)(o + 4) = (f32x4){v[4], v[5], v[6], v[7]};
                        }
                }
            }
            return;
        }
#pragma unroll
        for (int ai = 0; ai < 2; ++ai)
#pragma unroll
            for (int m = 0; m < 4; ++m) {
                const int r = ai * 128 + m * 16 + r0; const int lr = u.pm * 256 + r;
                float rs = 1.f, rss = 0.f;
                const bool rs_lds = (mode == M_PB || mode == M_UP || mode == M_PG) && ((u.pm >> 3) << 3) == rsb;
                if (rs_lds) rs = ev[(u.pm & 7) * 256 + r];
                if (!rs_lds && (mode == M_UP || mode == M_PG)) { const f32x4* sp = (const f32x4*)((const float*)(ws + WS_SSX) + (size_t)lr * 16); float s = 0.f;
#pragma unroll
                    for (int q4 = 0; q4 < 4; ++q4) { const f32x4 x = sp[q4]; s += (x[0] + x[1]) + (x[2] + x[3]); }
                    rs = rsqrtf(s * (1.f / 1024.f) + EPS); }
                if (!rs_lds && mode == M_PB) { const f32x4* sp = (const f32x4*)((const float*)(ws + WS_SSQ) + (size_t)lr * 32); float s = 0.f;
#pragma unroll
                    for (int q4 = 0; q4 < 8; ++q4) { const f32x4 x = sp[q4]; s += (x[0] + x[1]) + (x[2] + x[3]); }
                    rs = rsqrtf(s * (1.f / 2048.f) + EPS); }
#pragma unroll
                for (int bj = 0; bj < 2; ++bj) {
                    const int col = u.pn * 256 + bj * 128 + cb;
                    float a[8];
#pragma unroll
                    for (int e = 0; e < 8; ++e) a[e] = acc[ai][bj][m][e >> 2][e & 3];
                    if (mode == M_PA || mode == M_PB) {
                        bf16_t* mp = (bf16_t*)(ws + WS_H) + (size_t)lr * 1024 + col;
                        float gt[8]; unpack8(*(const u32x4*)((const bf16_t*)(ws + WS_GT) + (size_t)lr * 2048 + (mode == M_PB ? 1024 : 0) + col), gt);
                        float v[8];
                        if (mode == M_PA) {
#pragma unroll
                            for (int e = 0; e < 8; ++e) v[e] = gt[e] * a[e];
                        } else {
                            float s[8]; unpack8(*(const u32x4*)mp, s);
#pragma unroll
                            for (int e = 0; e < 8; ++e) v[e] = s[e] + gt[e] * rs * a[e];
                        }
                        *(u32x4*)mp = pack8(v);
                    } else if (mode == M_OUT || mode == M_DOWN) {
                        bf16_t* xbp = (bf16_t*)(ws + WS_XB) + (size_t)lr * 1024 + col;
                        float v[8];
                        if (mode == M_OUT) {
                            const float* xr = (lr < GROWS ? xp + ((size_t)g * GROWS + lr) * DM : xs + (size_t)(lr - GROWS) * DM) + col;
                            const f32x4 x0 = *(const f32x4*)xr, x1 = *(const f32x4*)(xr + 4);
                            v[0] = x0[0]; v[1] = x0[1]; v[2] = x0[2]; v[3] = x0[3]; v[4] = x1[0]; v[5] = x1[1]; v[6] = x1[2]; v[7] = x1[3];
                        } else unpack8(*(const u32x4*)xbp, v);
#pragma unroll
                        for (int e = 0; e < 8; ++e) v[e] += a[e];
                        *(u32x4*)xbp = pack8(v);
#pragma unroll
                        for (int e = 0; e < 8; ++e) rss += v[e] * v[e];
                    } else if (mode == M_UP) {
#pragma unroll
                        for (int e = 0; e < 8; ++e) a[e] *= rs;
                        *(u32x4*)((bf16_t*)(ws + WS_U) + (size_t)lr * 6144 + col) = pack8(a);
                        int b, t, len; if (smp) { b = r >> 5; t = r & 31; len = 32; } else { b = g * 8 + (u.pm >> 3); t = (u.pm & 7) * 256 + r; len = 2048; }
                        if (t >= len - 2) {
                            float* o = smp ? out + O_CFS + ((size_t)b * 2 + (t - 30)) * 6144 + col : out + O_CFP + ((size_t)b * 2 + (t - 2046)) * 6144 + col;
                            *(f32x4*)o = (f32x4){a[0], a[1], a[2], a[3]}; *(f32x4*)(o + 4) = (f32x4){a[4], a[5], a[6], a[7]};
                        }
                    } else if (mode == M_PG) {
                        float v[8];
#pragma unroll
                        for (int e = 0; e < 8; ++e) v[e] = sigmoidf_(a[e] * rs);
                        *(u32x4*)((bf16_t*)(ws + WS_ST) + (size_t)lr * 1024 + col) = pack8(v);
                    } else {
                        float s[8]; unpack8(*(const u32x4*)((const bf16_t*)(ws + WS_ST) + (size_t)lr * 1024 + col), s);
                        float xv[8]; unpack8(*(const u32x4*)((const bf16_t*)(ws + WS_XB) + (size_t)lr * 1024 + col), xv);
                        float* yr = (lr < GROWS ? out + O_YP + ((size_t)g * GROWS + lr) * DM : out + O_YS + (size_t)(lr - GROWS) * DM) + col;
                        *(f32x4*)yr = (f32x4){xv[0] + s[0] * a[0], xv[1] + s[1] * a[1], xv[2] + s[2] * a[2], xv[3] + s[3] * a[3]};
                        *(f32x4*)(yr + 4) = (f32x4){xv[4] + s[4] * a[4], xv[5] + s[5] * a[5], xv[6] + s[6] * a[6], xv[7] + s[7] * a[7]};
                    }
                }
                if (mode == M_OUT || mode == M_DOWN) {
                    rss += __shfl_xor(rss, 16); rss += __shfl_xor(rss, 32);
                    if (fq == 0) ((float*)(ws + WS_SSX))[(size_t)lr * 16 + u.pn * 4 + wc] = rss;
                }
            }
    }
};

__device__ __forceinline__ void run_gemm(LAS unsigned char* lds, const Params& P, int mode, int g, const bf16_t* A, const bf16_t* Bt, int M, int N, int K, int wv) {
    pg8::Gemm gm{A, Bt, M, N, K}; pg8::StaticOrder S; S.init(M, N, (int)gridDim.x, lbid());
    if (mode == M_IN) {
        LAS float* ev = (LAS float*)(lds + 131072); const int t_ = ltid_w(wv);
        for (int i = t_; i < 2304; i += 512) ev[i] = i < 64 ? P.in[I_GQ][i] : (i < 128 ? P.in[I_GK][i - 64] : (i < 160 ? P.in[I_DTB][i - 128] : (i < 256 ? 0.f : P.in[I_BGATE][i - 256])));
        __syncthreads();
    }
    int rsb_ = -1;
    if (mode == M_PB || mode == M_UP || mode == M_PG) {
        pg8::Unit u0; const bool has_ = S.next(0, u0);
        if (has_) {
            rsb_ = (u0.pm >> 3) << 3;
            LAS float* rt = (LAS float*)(lds + 131072); const int t_ = ltid_w(wv); const unsigned char* ws_ = lws(P);
            for (int r = t_; r < 2048; r += 512) {
                const int lr = rsb_ * 256 + r; float s = 0.f;
                if (lr < M) {
                    if (mode == M_PB) { const f32x4* sp = (const f32x4*)((const float*)(ws_ + WS_SSQ) + (size_t)lr * 32);
#pragma unroll
                        for (int q4 = 0; q4 < 8; ++q4) { const f32x4 x = sp[q4]; s += (x[0] + x[1]) + (x[2] + x[3]); }
                        s = rsqrtf(s * (1.f / 2048.f) + EPS);
                    } else { const f32x4* sp = (const f32x4*)((const float*)(ws_ + WS_SSX) + (size_t)lr * 16);
#pragma unroll
                        for (int q4 = 0; q4 < 4; ++q4) { const f32x4 x = sp[q4]; s += (x[0] + x[1]) + (x[2] + x[3]); }
                        s = rsqrtf(s * (1.f / 1024.f) + EPS);
                    }
                }
                rt[r] = s;
            }
        }
        __syncthreads();
    }
    Epi E{P.in[I_XP], P.in[I_XS], P.in[I_GQ], P.in[I_GK], P.in[I_BGATE], P.in[I_DTB], P.out, lws(P), mode, g, (const LAS float*)(lds + 131072), rsb_};
    pg8::gemm_phase<Epi, pg8::StaticOrder, true, true>(lds, gm, S, E, ltid_w(wv));
    __syncthreads();
}

__device__ __forceinline__ void tr_item(const float* W, int ldsrc, int srccol0, int k0, bf16_t* WT, size_t dstrow0, int ldd, const float* kscale, LAS float* scr, int lane) {
#pragma unroll
    for (int i = 0; i < 8; ++i) { const int kk = 8 * i + (lane >> 3), c4 = (lane & 7) * 4; f32x4 v = (f32x4){0.f, 0.f, 0.f, 0.f};
        if (srccol0 >= 0) { v = *(const f32x4*)(W + (size_t)(k0 + kk) * ldsrc + srccol0 + c4); if (kscale) v = v * kscale[k0 + kk]; }
        scr[kk * 33 + c4] = v[0]; scr[kk * 33 + c4 + 1] = v[1]; scr[kk * 33 + c4 + 2] = v[2]; scr[kk * 33 + c4 + 3] = v[3]; }
    asm volatile("s_waitcnt lgkmcnt(0)" ::: "memory");
    const int c = lane & 7;
#pragma unroll
    for (int j = 0; j < 4; ++j) { const int n = (lane >> 3) + 8 * j; const LAS float* s = scr + (8 * c) * 33 + n;
        u32x4 o; o.x = pk2(s[0 * 33], s[1 * 33]); o.y = pk2(s[2 * 33], s[3 * 33]); o.z = pk2(s[4 * 33], s[5 * 33]); o.w = pk2(s[6 * 33], s[7 * 33]);
        *(u32x4*)(WT + (dstrow0 + n) * (size_t)ldd + k0 + 8 * c) = o; }
    asm volatile("s_waitcnt lgkmcnt(0)" ::: "memory");
}
__device__ __forceinline__ int win_srccol(int n0) {
    const int tile = n0 >> 8, tc = n0 & 255;
    if (tile < 8) { const int bj = tc >> 7, wc = (tc & 127) >> 5; return (tile < 4 ? 0 : 1024) + (4 * (tile & 3) + wc) * 64 + 32 * bj; }
    if (tile < 12) return 2048 + (tile - 8) * 256 + tc;
    if (tile < 20) return 3072 + (tile - 12) * 256 + tc;
    if (tile < 32) return 5120 + (tile - 20) * 256 + tc;
    if (tile < 40) return 8224 + (tile - 32) * 256 + tc;
    return tc < 32 ? 8192 + tc : -1;
}
__device__ __forceinline__ void tr_matrix(const float* W, int K, int ldsrc, int Ndst, bool winmap, bf16_t* WT, int ldd, const float* kscale, LAS float* scr, int gw, int NGW, int lane) {
    const int nblk = Ndst / 32, nit = (K / 64) * nblk;
    for (int it = gw; it < nit; it += NGW) { const int kb = it / nblk, nb = it % nblk; tr_item(W, ldsrc, winmap ? win_srccol(nb * 32) : nb * 32, kb * 64, WT, (size_t)nb * 32, ldd, kscale, scr, lane); }
}
__device__ __forceinline__ void prologue(const Params& P, LAS unsigned char* lds, int wv) {
    const int tid = ltid_w(wv), lane = tid & 63, wave = tid >> 6;
    LAS float* scr = (LAS float*)(lds + wave * 16384);
    const int gw = lbid() * 8 + wave, NGW = gridDim.x * 8;
    unsigned char* ws = lws(P);
    tr_matrix(P.in[I_WIN], 1024, NIN, NINP, true, (bf16_t*)(ws + WS_W1T), 1024, nullptr, scr, gw, NGW, lane);
    tr_matrix(P.in[I_WUP], 1024, 6144, 6144, false, (bf16_t*)(ws + WS_WUT), 1024, P.in[I_GFFN], scr, gw, NGW, lane);
    tr_matrix(P.in[I_WDOWN], 3072, 1024, 1024, false, (bf16_t*)(ws + WS_WDT), 3072, nullptr, scr, gw, NGW, lane);
    tr_matrix(P.in[I_WPB], 2048, 1024, 1024, false, (bf16_t*)(ws + WS_WBT), 2048, P.in[I_GSSM], scr, gw, NGW, lane);
    tr_matrix(P.in[I_WPA], 1024, 1024, 1024, false, (bf16_t*)(ws + WS_WAT), 1024, nullptr, scr, gw, NGW, lane);
    tr_matrix(P.in[I_WOUT], 1024, 1024, 1024, false, (bf16_t*)(ws + WS_WOT), 1024, nullptr, scr, gw, NGW, lane);
    tr_matrix(P.in[I_WPG], 1024, 1024, 1024, false, (bf16_t*)(ws + WS_WGT), 1024, P.in[I_GPLE], scr, gw, NGW, lane);
    tr_matrix(P.in[I_WPLE], 256, 1024, 1024, false, (bf16_t*)(ws + WS_WPT), 256, nullptr, scr, gw, NGW, lane);
    const size_t gt = (size_t)lbid() * 512 + tid, GT = (size_t)gridDim.x * 512;
    for (size_t i = gt; i < (size_t)8 * 512 * 128; i += GT) {
        const size_t b = i / (512 * 128), t = (i / 128) % 512, c8 = i % 128, head = c8 >> 3, d8 = c8 & 7;
        const f32x4 a = *(const f32x4*)(P.in[I_CK] + i * 8), c = *(const f32x4*)(P.in[I_CK] + i * 8 + 4);
        u32x4 w; w.x = pk2(a[0], a[1]); w.y = pk2(a[2], a[3]); w.z = pk2(c[0], c[1]); w.w = pk2(c[2], c[3]);
        *(u32x4*)((bf16_t*)(ws + WS_KS) + (b * 16 + head) * 576 * 64 + (t >> 4) * 1024 + (d8 >> 2) * 512 + (d8 & 3) * 128 + (t & 15) * 8) = w;
    }
    for (size_t i = gt; i < (size_t)8 * 16 * 256; i += GT) { const size_t bh = i / 256, rem = i % 256; *(u32x4*)((bf16_t*)(ws + WS_KS) + bh * 576 * 64 + (size_t)34 * 1024 + rem * 8) = (u32x4){0, 0, 0, 0}; }
    for (size_t i = gt; i < (size_t)8 * 128 * 128; i += GT) {
        const size_t b = i / (128 * 128), tg = (i / 128) % 128, c8 = i % 128;
        float v[4][8];
#pragma unroll
        for (int k = 0; k < 4; ++k) { const float* sp = P.in[I_CV] + ((b * 512 + tg * 4 + k) * 1024 + c8 * 8); const f32x4 a = *(const f32x4*)sp, c = *(const f32x4*)(sp + 4); v[k][0] = a[0]; v[k][1] = a[1]; v[k][2] = a[2]; v[k][3] = a[3]; v[k][4] = c[0]; v[k][5] = c[1]; v[k][6] = c[2]; v[k][7] = c[3]; }
        bf16_t* dp = (bf16_t*)(ws + WS_VTS) + b * 576 * 1024 + (tg * 1024 + c8 * 8) * 4;
#pragma unroll
        for (int e = 0; e < 8; e += 2) { u32x4 w; w.x = pk2(v[0][e], v[1][e]); w.y = pk2(v[2][e], v[3][e]); w.z = pk2(v[0][e + 1], v[1][e + 1]); w.w = pk2(v[2][e + 1], v[3][e + 1]); *(u32x4*)(dp + e * 4) = w; }
    }
    for (size_t i = gt; i < (size_t)8 * 8 * 512; i += GT) { const size_t b = i / (8 * 512), rem = i % (8 * 512); *(u32x4*)((bf16_t*)(ws + WS_VTS) + b * 576 * 1024 + (size_t)136 * 4096 + rem * 8) = (u32x4){0, 0, 0, 0}; }
}

__device__ __forceinline__ void norm_pass(const Params& P, int g, int wv) {
    const int tid = ltid_w(wv), lane = tid & 63, wave = tid >> 6;
    const int gw = lbid() * 8 + wave, NGW = gridDim.x * 8, nr = grows(g);
    const float* gvec = P.in[I_GMIX];
    f32x4 gv[4];
#pragma unroll
    for (int j = 0; j < 4; ++j) gv[j] = *(const f32x4*)(gvec + 4 * lane + 256 * j);
    unsigned char* ws = lws(P);
    bf16_t* dst = (bf16_t*)(ws + (g == 0 ? WS_H : WS_H1)); bf16_t* ped = (bf16_t*)(ws + (g == 0 ? WS_PE : WS_PE1));
    for (int lr = gw; lr < nr; lr += NGW) {
        const float* src = xrow(P, g, lr);
        f32x4 v[4]; float s = 0.f;
#pragma unroll
        for (int j = 0; j < 4; ++j) { v[j] = *(const f32x4*)(src + 4 * lane + 256 * j); s += v[j][0] * v[j][0] + v[j][1] * v[j][1] + v[j][2] * v[j][2] + v[j][3] * v[j][3]; }
        const float rs = rsqrtf(wave_sum(s) * (1.f / 1024.f) + EPS);
#pragma unroll
        for (int j = 0; j < 4; ++j) { u32x2 w; w.x = pk2(v[j][0] * rs * gv[j][0], v[j][1] * rs * gv[j][1]); w.y = pk2(v[j][2] * rs * gv[j][2], v[j][3] * rs * gv[j][3]); *(u32x2*)(dst + (size_t)lr * 1024 + 4 * lane + 256 * j) = w; }
        const float* pr = lr < GROWS ? P.in[I_PP] + ((size_t)g * GROWS + lr) * PLE : P.in[I_PS] + (size_t)(lr - GROWS) * PLE;
        const f32x4 pv = *(const f32x4*)(pr + 4 * lane); u32x2 w; w.x = pk2(pv[0], pv[1]); w.y = pk2(pv[2], pv[3]);
        *(u32x2*)(ped + (size_t)lr * PLE + 4 * lane) = w;
    }
}

__device__ __forceinline__ bf16_t* bcc_row(const Params& P, int g, int lr) {
    return lr < GROWS ? (bf16_t*)(P.out + O_YP + (size_t)g * GROWS * DM) + (size_t)lr * 1024 : (bf16_t*)(P.out + O_YS) + (size_t)(lr - GROWS) * 1024;
}
__device__ __forceinline__ void bc_prepass(const Params& P, int g, int wv) {
    const size_t gt = (size_t)lbid() * 512 + ltid_w(wv), GT = (size_t)gridDim.x * 512;
    unsigned char* ws = lws(P);
    const bf16_t* xbc = (const bf16_t*)(ws + WS_XBC);
    const size_t n = (size_t)(grows(g) / 8) * 128;
    for (size_t i = gt; i < n; i += GT) {
        const int rg = (int)(i / 128), c0 = (int)(i % 128) * 8, lr0 = rg * 8, ch = 2048 + c0;
        int t0, sb = 0; const bool smp = lr0 >= GROWS; if (smp) { sb = (lr0 - GROWS) >> 5; t0 = (lr0 - GROWS) & 31; } else t0 = lr0 & 2047;
        float w[5][8];
#pragma unroll
        for (int k = 0; k < 5; ++k) { const float* wp = (k < 4 ? P.in[I_CSW] + k * 3072 : P.in[I_CSB]) + ch; const f32x4 a = *(const f32x4*)wp, b2 = *(const f32x4*)(wp + 4);
            w[k][0] = a[0]; w[k][1] = a[1]; w[k][2] = a[2]; w[k][3] = a[3]; w[k][4] = b2[0]; w[k][5] = b2[1]; w[k][6] = b2[2]; w[k][7] = b2[3]; }
        float pa[8], pb[8], pc[8];
#pragma unroll
        for (int k = 0; k < 3; ++k) {
            float* dst = k == 0 ? pa : (k == 1 ? pb : pc);
            if (t0 > 0) unpack8(*(const u32x4*)(xbc + (size_t)(lr0 - 3 + k) * 3072 + ch), dst);
            else if (smp) { const float* cp = P.in[I_CSSM] + ((size_t)sb * 3 + k) * 3072 + ch; const f32x4 a = *(const f32x4*)cp, b2 = *(const f32x4*)(cp + 4); dst[0] = a[0]; dst[1] = a[1]; dst[2] = a[2]; dst[3] = a[3]; dst[4] = b2[0]; dst[5] = b2[1]; dst[6] = b2[2]; dst[7] = b2[3]; }
            else {
#pragma unroll
                for (int e = 0; e < 8; ++e) dst[e] = 0.f;
            }
        }
#pragma unroll
        for (int r = 0; r < 8; ++r) {
            float cur[8], o[8];
            unpack8(*(const u32x4*)(xbc + (size_t)(lr0 + r) * 3072 + ch), cur);
#pragma unroll
            for (int e = 0; e < 8; ++e) { o[e] = siluf_(w[4][e] + w[0][e] * pa[e] + w[1][e] * pb[e] + w[2][e] * pc[e] + w[3][e] * cur[e]); pa[e] = pb[e]; pb[e] = pc[e]; pc[e] = cur[e]; }
            *(u32x4*)(bcc_row(P, g, lr0 + r) + c0) = pack8(o);
        }
    }
}

#define MFMA16(a, b, c) __builtin_amdgcn_mfma_f32_16x16x32_bf16((a), (b), (c), 0, 0, 0)
#define VMWAIT0() asm volatile("s_waitcnt vmcnt(0)" ::: "memory")
constexpr int SSD_RAW = 108800, SSD_ZS = 148608;
__device__ __forceinline__ int ssd_chmap(int c0, int h, int grp) { return c0 < 64 ? h * 64 + c0 : (c0 < 192 ? 2048 + grp * 128 + (c0 - 64) : 2560 + grp * 128 + (c0 - 192)); }
__device__ __forceinline__ void ssd_item(const Params& P, LAS unsigned char* lds, int g, int item, int wv) {
    const int tid = ltid_w(wv), lane = tid & 63, wave = __builtin_amdgcn_readfirstlane(tid >> 6), fr = lane & 15, fq = lane >> 4;
    unsigned char* ws = lws(P);
    const bool smp = item >= 256;
    const int sq = smp ? (item - 256) >> 5 : item >> 5, h = item & 31, grp = h >> 3;
    const int lr0 = smp ? GROWS + sq * 32 : sq * 2048, L = smp ? 32 : 64, nch = smp ? 1 : 32;
    LAS bf16_t* Xt = (LAS bf16_t*)(lds);
    LAS bf16_t* Xwt = (LAS bf16_t*)(lds + 10240);
    LAS bf16_t* Bm = (LAS bf16_t*)(lds + 20480);
    LAS bf16_t* Bt = (LAS bf16_t*)(lds + 38912);
    LAS bf16_t* Cm = (LAS bf16_t*)(lds + 59392);
    LAS bf16_t* Gm = (LAS bf16_t*)(lds + 77824);
    LAS bf16_t* Hb = (LAS bf16_t*)(lds + 88064);
    LAS float* sacs = (LAS float*)(lds + 107776);
    LAS float* sdt = sacs + 64;
    LAS float* sred = sacs + 128;
    LAS unsigned char* rawb = lds + SSD_RAW;
    LAS bf16_t* Zs = (LAS bf16_t*)(lds + SSD_ZS);
    const float aneg = -__expf(P.in[I_ALOG][h]), dskip = P.in[I_DSKIP][h];
    const bf16_t* xbc = (const bf16_t*)(ws + WS_XBC);
    const float* dtp = (const float*)(ws + WS_DT);
    bf16_t* zb = (bf16_t*)(ws + WS_Z);
    float* ssq = (float*)(ws + WS_SSQ);
    LAS float* cw = (LAS float*)(lds + 106496);
    for (int i = tid; i < 5 * 64; i += 512) { const int k = i >> 6, cc = i & 63; cw[i] = k < 4 ? P.in[I_CSW][k * 3072 + h * 64 + cc] : P.in[I_CSB][h * 64 + cc]; }
    const bf16_t* bcc0 = bcc_row(P, g, 0);
    const int pbH = wave >> 1, nbH0 = 4 * (wave & 1);
    f32x4 Hacc[4];
#pragma unroll
    for (int tt = 0; tt < 4; ++tt) {
        Hacc[tt] = (f32x4){0.f, 0.f, 0.f, 0.f};
        if (smp) Hacc[tt] = *(const f32x4*)(P.in[I_SSM] + (((size_t)sq * 32 + h) * 64 + pbH * 16 + fr) * 128 + (nbH0 + tt) * 16 + 4 * fq);
        u32x2 w; w.x = pk2(Hacc[tt][0], Hacc[tt][1]); w.y = pk2(Hacc[tt][2], Hacc[tt][3]);
        *(LAS u32x2*)(Hb + (pbH * 16 + fr) * 144 + (nbH0 + tt) * 16 + 4 * fq) = w;
    }
#define SSD_RAW_DMA(cc) do { const int tokc0_ = lr0 + (cc) * L; _Pragma("unroll") for (int k_ = 0; k_ < 6; ++k_) { const int sb_ = (k_ * 8 + wave) * 64; if (sb_ < 2747) { const int s_ = sb_ + lane, row_ = s_ / 41, o_ = s_ - row_ * 41; \
        const bool ok_ = (s_ < 2747) && (o_ < 40) && ((cc) > 0 || row_ >= 3) && (row_ - 3 < L) && (o_ < 8 || row_ >= 3); \
        const int lrr_ = tokc0_ - 3 + row_; \
        const bf16_t* src_ = o_ < 8 ? xbc + (size_t)lrr_ * 3072 + h * 64 + o_ * 8 : (smp ? bcc_s : bcc0) + (size_t)(smp ? lrr_ - GROWS : lrr_) * 1024 + (o_ < 24 ? grp * 128 + (o_ - 8) * 8 : 512 + grp * 128 + (o_ - 24) * 8); \
        if (ok_) __builtin_amdgcn_global_load_lds((const unsigned*)src_, (LAS unsigned*)(rawb + sb_ * 16), 16, 0, 0); } } } while (0)
    const bf16_t* bcc_s = bcc_row(P, g, GROWS);
    SSD_RAW_DMA(0);
    if (tid < 120) {
        const int row = tid / 40, o = tid - row * 40; u32x4 w = (u32x4){0u, 0u, 0u, 0u};
        if (smp && o < 8) { const float* cp = P.in[I_CSSM] + ((size_t)sq * 3 + row) * 3072 + h * 64 + o * 8; const f32x4 a = *(const f32x4*)cp, b2 = *(const f32x4*)(cp + 4); float v[8] = {a[0], a[1], a[2], a[3], b2[0], b2[1], b2[2], b2[3]}; w = pack8(v); }
        *(LAS u32x4*)(rawb + (row * 41 + o) * 16) = w;
    }
    float dtn = lane < L ? dtp[(size_t)(lr0 + lane) * 32 + h] : 0.f;
    VMWAIT0(); __syncthreads();
    for (int c = 0; c < nch; ++c) {
        const int tok0 = lr0 + c * L;
        u32x2 zreg[2];
        { const int i_ = (wave >> 1) * 16 + fr;
#pragma unroll
          for (int tt = 0; tt < 2; ++tt) { zreg[tt] = (u32x2){0u, 0u}; if (i_ < L) zreg[tt] = *(const u32x2*)(zb + (size_t)(tok0 + i_) * 2048 + h * 64 + (2 * (wave & 1) + tt) * 16 + 4 * fq); } }
        const float dtl = dtn;
        if (c + 1 < nch) dtn = dtp[(size_t)(tok0 + L + lane) * 32 + h];
        float acs = dtl * aneg;
#pragma unroll
        for (int o = 1; o < 64; o <<= 1) { const float t = __shfl_up(acs, o); if (lane >= o) acs += t; }
        const float last = __shfl(acs, 63);
        if (wave == 0) { sacs[lane] = acs; sdt[lane] = dtl; if (c > 0 && lane < L) ssq[(size_t)(tok0 - L + lane) * 32 + h] = sred[lane] + sred[64 + lane]; }
        {
            const int j = lane, xo = wave, c0 = xo * 8;
            float v[8];
#pragma unroll
            for (int e = 0; e < 8; ++e) v[e] = cw[256 + c0 + e];
#pragma unroll
            for (int i = 0; i < 4; ++i) { float r[8]; unpack8(*(const LAS u32x4*)(rawb + ((j + i) * 41 + xo) * 16), r);
#pragma unroll
                for (int e = 0; e < 8; ++e) v[e] += cw[i * 64 + c0 + e] * r[e]; }
            const float wj = __expf(last - acs) * dtl;
#pragma unroll
            for (int e = 0; e < 8; ++e) { const float x = j < L ? siluf_(v[e]) : 0.f; Xt[(c0 + e) * 80 + j] = (bf16_t)(pk2(x, 0.f) & 0xffffu); Xwt[(c0 + e) * 80 + j] = (bf16_t)(pk2(x * wj, 0.f) & 0xffffu); }
#pragma unroll
            for (int k = 0; k < 4; ++k) {
                const int jj = lane, o2 = wave + 8 * k;
                u32x4 w = (u32x4){0u, 0u, 0u, 0u};
                if (jj < L) w = *(const LAS u32x4*)(rawb + ((jj + 3) * 41 + 8 + o2) * 16);
                if (o2 < 16) {
                    *(LAS u32x4*)(Bm + jj * 144 + o2 * 8) = w;
                    LAS bf16_t* bt = Bt + (o2 * 8) * 80 + jj;
                    bt[0 * 80] = (bf16_t)(w.x & 0xffffu); bt[1 * 80] = (bf16_t)(w.x >> 16); bt[2 * 80] = (bf16_t)(w.y & 0xffffu); bt[3 * 80] = (bf16_t)(w.y >> 16);
                    bt[4 * 80] = (bf16_t)(w.z & 0xffffu); bt[5 * 80] = (bf16_t)(w.z >> 16); bt[6 * 80] = (bf16_t)(w.w & 0xffffu); bt[7 * 80] = (bf16_t)(w.w >> 16);
                } else {
                    *(LAS u32x4*)(Cm + jj * 144 + (o2 - 16) * 8) = w;
                }
            }
        }
        asm volatile("s_waitcnt lgkmcnt(0)" ::: "memory"); __builtin_amdgcn_s_barrier(); asm volatile("" ::: "memory");
        if (c + 1 < nch) SSD_RAW_DMA(c + 1);
        const int ib = wave >> 1;
        const float acsi = sacs[ib * 16 + fr];
        f32x4 yin[2];
#pragma unroll
        for (int tt = 0; tt < 2; ++tt) {
            const int jb = 2 * (wave & 1) + tt;
            f32x4 cbv = (f32x4){0.f, 0.f, 0.f, 0.f};
            if (jb <= ib) {
#pragma unroll
                for (int ks = 0; ks < 4; ++ks) {
                    const bf16x8 a = *(const LAS bf16x8*)(Bm + (jb * 16 + fr) * 144 + ks * 32 + fq * 8);
                    const bf16x8 b2 = *(const LAS bf16x8*)(Cm + (ib * 16 + fr) * 144 + ks * 32 + fq * 8);
                    cbv = MFMA16(a, b2, cbv);
                }
                const int i = ib * 16 + fr;
#pragma unroll
                for (int e = 0; e < 4; ++e) { const int j = jb * 16 + 4 * fq + e; cbv[e] = (j <= i) ? cbv[e] * __expf(acsi - sacs[j]) * sdt[j] : 0.f; }
            }
            u32x2 w; w.x = pk2(cbv[0], cbv[1]); w.y = pk2(cbv[2], cbv[3]);
            *(LAS u32x2*)(Gm + (ib * 16 + fr) * 80 + jb * 16 + 4 * fq) = w;
            const int pb = jb;
            f32x4 y = (f32x4){0.f, 0.f, 0.f, 0.f};
#pragma unroll
            for (int ks = 0; ks < 4; ++ks) {
                const bf16x8 a = *(const LAS bf16x8*)(Hb + (pb * 16 + fr) * 144 + ks * 32 + fq * 8);
                const bf16x8 b2 = *(const LAS bf16x8*)(Cm + (ib * 16 + fr) * 144 + ks * 32 + fq * 8);
                y = MFMA16(a, b2, y);
            }
            yin[tt] = y;
        }
        asm volatile("s_waitcnt lgkmcnt(0)" ::: "memory"); __builtin_amdgcn_s_barrier(); asm volatile("" ::: "memory");
        {
            const int i = ib * 16 + fr; const float eai = __expf(acsi); float ss = 0.f;
#pragma unroll
            for (int tt = 0; tt < 2; ++tt) {
                const int pb = 2 * (wave & 1) + tt;
                f32x4 y = (f32x4){0.f, 0.f, 0.f, 0.f};
#pragma unroll
                for (int ks = 0; ks < 2; ++ks) {
                    const bf16x8 a = *(const LAS bf16x8*)(Xt + (pb * 16 + fr) * 80 + ks * 32 + fq * 8);
                    const bf16x8 b2 = *(const LAS bf16x8*)(Gm + (ib * 16 + fr) * 80 + ks * 32 + fq * 8);
                    y = MFMA16(a, b2, y);
                }
                if (i < L) {
                    const u32x2 zw = zreg[tt];
                    const float sz[4] = {siluf_(bflo(zw.x)), siluf_(bfhi(zw.x)), siluf_(bflo(zw.y)), siluf_(bfhi(zw.y))};
                    float o[4];
#pragma unroll
                    for (int e = 0; e < 4; ++e) { const float xs = bf2f(Xt[(pb * 16 + 4 * fq + e) * 80 + i]); o[e] = (y[e] + eai * yin[tt][e] + dskip * xs) * sz[e]; ss += o[e] * o[e]; }
                    u32x2 w; w.x = pk2(o[0], o[1]); w.y = pk2(o[2], o[3]);
                    *(u32x2*)(zb + (size_t)(tok0 + i) * 2048 + h * 64 + pb * 16 + 4 * fq) = w;
                }
            }
            ss += __shfl_xor(ss, 16); ss += __shfl_xor(ss, 32);
            if (fq == 0) sred[(wave & 1) * 64 + i] = ss;
        }
        {
            const float el = __expf(last);
#pragma unroll
            for (int tt = 0; tt < 4; ++tt) {
                Hacc[tt] = Hacc[tt] * el;
#pragma unroll
                for (int ks = 0; ks < 2; ++ks) {
                    const bf16x8 a = *(const LAS bf16x8*)(Bt + ((nbH0 + tt) * 16 + fr) * 80 + ks * 32 + fq * 8);
                    const bf16x8 b2 = *(const LAS bf16x8*)(Xwt + (pbH * 16 + fr) * 80 + ks * 32 + fq * 8);
                    Hacc[tt] = MFMA16(a, b2, Hacc[tt]);
                }
            }
        }
#pragma unroll
        for (int tt = 0; tt < 4; ++tt) { u32x2 w; w.x = pk2(Hacc[tt][0], Hacc[tt][1]); w.y = pk2(Hacc[tt][2], Hacc[tt][3]); *(LAS u32x2*)(Hb + (pbH * 16 + fr) * 144 + (nbH0 + tt) * 16 + 4 * fq) = w; }
        if (smp) { asm volatile("s_waitcnt vmcnt(0) lgkmcnt(0)" ::: "memory"); } else { asm volatile("s_waitcnt vmcnt(2) lgkmcnt(0)" ::: "memory"); }
        __builtin_amdgcn_s_barrier(); asm volatile("" ::: "memory");
    }
    VMWAIT0(); __syncthreads();
    if (wave == 0 && lane < L) ssq[(size_t)(lr0 + (nch - 1) * L + lane) * 32 + h] = sred[lane] + sred[64 + lane];
    float* so = smp ? P.out + O_SSMS + (((size_t)sq * 32 + h) * 64) * 128 : P.out + O_SSMP + ((((size_t)g * 8 + sq) * 32 + h) * 64) * 128;
#pragma unroll
    for (int tt = 0; tt < 4; ++tt) *(f32x4*)(so + (size_t)(pbH * 16 + fr) * 128 + (nbH0 + tt) * 16 + 4 * fq) = Hacc[tt];
}

__device__ __forceinline__ void attn_wave(bf16_t* qo, const bf16_t* Kh, const bf16_t* Vth, int VP, int qpos0, int kstart, int seq_len, int t_lo, const LAS float* tbl, int lane) {
    const int fr = lane & 15, fq = lane >> 4;
    bf16x8 qf[2][2];
#pragma unroll
    for (int qb = 0; qb < 2; ++qb)
#pragma unroll
        for (int ks = 0; ks < 2; ++ks) qf[qb][ks] = *(const bf16x8*)(qo + (size_t)(qb * 16 + fr) * 1024 + ks * 32 + fq * 8);
    f32x4 o[2][4];
#pragma unroll
    for (int qb = 0; qb < 2; ++qb)
#pragma unroll
        for (int d = 0; d < 4; ++d) o[qb][d] = (f32x4){0.f, 0.f, 0.f, 0.f};
    float mrun[2] = {-1e30f, -1e30f}, lsum[2] = {0.f, 0.f};
    bf16x8 kc[4][2];
    {
        const int kt0 = kstart + 64 * t_lo;
#pragma unroll
        for (int blk = 0; blk < 4; ++blk) { const bf16_t* kp = Kh + (size_t)((kt0 >> 4) + blk) * 1024 + fq * 128 + fr * 8; kc[blk][0] = *(const bf16x8*)kp; kc[blk][1] = *(const bf16x8*)(kp + 512); }
    }
    const float bc = tbl[256];
    s16x4 vlo[4][2], vhi[4][2];
    {
        const int kt0 = kstart + 64 * t_lo;
#pragma unroll
        for (int d = 0; d < 4; ++d)
#pragma unroll
            for (int ks = 0; ks < 2; ++ks) { const bf16_t* vp = Vth + ((size_t)((kt0 + 32 * ks + 4 * fq) >> 2) * 1024 + d * 16 + fr) * 4; vlo[d][ks] = *(const s16x4*)vp; vhi[d][ks] = *(const s16x4*)(vp + 4 * 1024 * 4); }
    }
    for (int t = t_lo; t < 9; ++t) {
        const int kt0 = kstart + 64 * t, kt1 = kstart + 64 * (t < 8 ? t + 1 : t);
        s16x4 vnl[4][2], vnh[4][2];
#pragma unroll
        for (int d = 0; d < 4; ++d)
#pragma unroll
            for (int ks = 0; ks < 2; ++ks) { const bf16_t* vp = Vth + ((size_t)((kt1 + 32 * ks + 4 * fq) >> 2) * 1024 + d * 16 + fr) * 4; vnl[d][ks] = *(const s16x4*)vp; vnh[d][ks] = *(const s16x4*)(vp + 4 * 1024 * 4); }
        bf16x8 kn[4][2];
#pragma unroll
        for (int blk = 0; blk < 4; ++blk) { const bf16_t* kp = Kh + (size_t)((kt1 >> 4) + blk) * 1024 + fq * 128 + fr * 8; kn[blk][0] = *(const bf16x8*)kp; kn[blk][1] = *(const bf16x8*)(kp + 512); }
        f32x4 s[2][4];
#pragma unroll
        for (int qb = 0; qb < 2; ++qb)
#pragma unroll
            for (int blk = 0; blk < 4; ++blk) { f32x4 z = (f32x4){0.f, 0.f, 0.f, 0.f}; z = MFMA16(kc[blk][0], qf[qb][0], z); s[qb][blk] = MFMA16(kc[blk][1], qf[qb][1], z); }
        const bool cst = (qpos0 - (kt0 + 63)) >= 128;
        const bool tail = (kt0 + 64) > seq_len;
        bf16x8 pbv[2][2];
#pragma unroll
        for (int qb = 0; qb < 2; ++qb) {
            const int qpos = qpos0 + qb * 16 + fr;
            float mx = -1e30f, cc;
            if (cst && !tail) {
#pragma unroll
                for (int blk = 0; blk < 4; ++blk) mx = fmaxf(fmaxf(mx, fmaxf(s[qb][blk][0], s[qb][blk][1])), fmaxf(s[qb][blk][2], s[qb][blk][3]));
                mx += bc; cc = bc;
            } else {
#pragma unroll
                for (int blk = 0; blk < 4; ++blk)
#pragma unroll
                    for (int e = 0; e < 4; ++e) {
                        const int kpos = kt0 + blk * 16 + 4 * fq + e;
                        int rel = qpos - kpos; rel = rel < -128 ? -128 : (rel > 128 ? 128 : rel);
                        float v = s[qb][blk][e] + tbl[rel + 128];
                        if (tail && kpos >= seq_len) v = -1e30f;
                        s[qb][blk][e] = v; mx = fmaxf(mx, v);
                    }
                cc = 0.f;
            }
            mx = fmaxf(mx, __shfl_xor(mx, 16)); mx = fmaxf(mx, __shfl_xor(mx, 32));
            const float mnew = fmaxf(mrun[qb], mx), sc = __builtin_amdgcn_exp2f(mrun[qb] - mnew);
            mrun[qb] = mnew; cc -= mnew;
            float ps = 0.f;
#pragma unroll
            for (int blk = 0; blk < 4; ++blk)
#pragma unroll
                for (int e = 0; e < 4; ++e) { const float p = __builtin_amdgcn_exp2f(s[qb][blk][e] + cc); s[qb][blk][e] = p; ps += p; }
            lsum[qb] = lsum[qb] * sc + ps;
            if (__any(sc != 1.f)) {
#pragma unroll
                for (int d = 0; d < 4; ++d) o[qb][d] = o[qb][d] * sc;
            }
#pragma unroll
            for (int ks = 0; ks < 2; ++ks) {
                u32x4 pw; pw.x = pk2(s[qb][2 * ks][0], s[qb][2 * ks][1]); pw.y = pk2(s[qb][2 * ks][2], s[qb][2 * ks][3]); pw.z = pk2(s[qb][2 * ks + 1][0], s[qb][2 * ks + 1][1]); pw.w = pk2(s[qb][2 * ks + 1][2], s[qb][2 * ks + 1][3]);
                pbv[qb][ks] = __builtin_bit_cast(bf16x8, pw);
            }
        }
#pragma unroll
        for (int ks = 0; ks < 2; ++ks)
#pragma unroll
            for (int d = 0; d < 4; ++d) {
                const bf16x8 a = (bf16x8){vlo[d][ks][0], vlo[d][ks][1], vlo[d][ks][2], vlo[d][ks][3], vhi[d][ks][0], vhi[d][ks][1], vhi[d][ks][2], vhi[d][ks][3]};
                o[0][d] = MFMA16(a, pbv[0][ks], o[0][d]); o[1][d] = MFMA16(a, pbv[1][ks], o[1][d]);
            }
#pragma unroll
        for (int blk = 0; blk < 4; ++blk) { kc[blk][0] = kn[blk][0]; kc[blk][1] = kn[blk][1]; }
#pragma unroll
        for (int d = 0; d < 4; ++d)
#pragma unroll
            for (int ks = 0; ks < 2; ++ks) { vlo[d][ks] = vnl[d][ks]; vhi[d][ks] = vnh[d][ks]; }
    }
#pragma unroll
    for (int qb = 0; qb < 2; ++qb) {
        float l = lsum[qb]; l += __shfl_xor(l, 16); l += __shfl_xor(l, 32);
        const float inv = 1.f / l;
#pragma unroll
        for (int d = 0; d < 4; ++d) { u32x2 w; w.x = pk2(o[qb][d][0] * inv, o[qb][d][1] * inv); w.y = pk2(o[qb][d][2] * inv, o[qb][d][3] * inv); *(u32x2*)(qo + (size_t)(qb * 16 + fr) * 1024 + d * 16 + 4 * fq) = w; }
    }
}

__device__ __forceinline__ void mixer_phase(const Params& P, LAS unsigned char* lds, int g, int wv) {
    const int tid = ltid_w(wv), lane = tid & 63, wave = __builtin_amdgcn_readfirstlane(tid >> 6);
    unsigned char* ws = lws(P);
    const int nssd = g == 0 ? 256 : 512;
    for (int it = lbid(); it < nssd; it += gridDim.x) { ssd_item(P, lds, g, it, wv); __syncthreads(); }
    LAS float* tbl = (LAS float*)lds;
    for (int i = tid; i < 16 * 257; i += 512) tbl[i] = P.in[I_REL][i] * LOG2E;
    __syncthreads();
    bf16_t* q = (bf16_t*)(ws + WS_Q);
    const int nblk = 8 * 32 * 4 + (g == 1 ? 16 : 0);
    const int abx_ = lbid(), aG_ = (int)gridDim.x, avcu = (aG_ % 8 == 0) ? (abx_ % 8) * (aG_ / 8) + abx_ / 8 : abx_;
    for (int bu = avcu; bu < nblk; bu += aG_) {
        if (bu < 1024) {
            const int bl = bu >> 7, c = (bu >> 2) & 31, h = (bu & 3) * 4 + (wave >> 1), half = wave & 1;
            const int qpos0 = c * 64 + half * 32;
            attn_wave(q + ((size_t)bl * 2048 + qpos0) * 1024 + h * 64, (const bf16_t*)(ws + WS_K) + ((size_t)bl * 16 + h) * 2048 * 64,
                      (const bf16_t*)(ws + WS_VT) + (size_t)bl * 2048 * 1024 + h * 64 * 4, 2048, qpos0, c * 64 - 512, 2048, c < 8 ? 8 - c : 0, tbl + h * 257, lane);
        } else {
            const int wi = (bu - 1024) * 8 + wave, sb = wi >> 4, h = wi & 15;
            attn_wave(q + ((size_t)GROWS + sb * 32) * 1024 + h * 64, (const bf16_t*)(ws + WS_KS) + ((size_t)sb * 16 + h) * 576 * 64,
                      (const bf16_t*)(ws + WS_VTS) + (size_t)sb * 576 * 1024 + h * 64 * 4, 576, 512, 0, 544, 0, tbl + h * 257, lane);
        }
    }
}

__device__ __forceinline__ void sg_kloop(f32x4 (&acc)[4], const bf16_t* A, const bf16_t* Bt, int K, int row0, int col0, int wave, int fr, int fq) {
    const int ksub = K >> 3, k0 = wave * ksub;
    const bf16_t* ap = A + (size_t)(row0 + fr) * K + k0 + fq * 8;
    const bf16_t* bp = Bt + (size_t)(col0 + fr) * K + k0 + fq * 8;
    if (ksub >= 128) {
        for (int kk = 0; kk < ksub; kk += 128) {
            bf16x8 a[4], bq[4][4];
#pragma unroll
            for (int s = 0; s < 4; ++s) { a[s] = *(const bf16x8*)(ap + kk + 32 * s);
#pragma unroll
                for (int t = 0; t < 4; ++t) bq[s][t] = *(const bf16x8*)(bp + (size_t)(16 * t) * K + kk + 32 * s); }
#pragma unroll
            for (int s = 0; s < 4; ++s)
#pragma unroll
                for (int t = 0; t < 4; ++t) acc[t] = MFMA16(bq[s][t], a[s], acc[t]);
        }
    } else {
        for (int kk = 0; kk < ksub; kk += 32) {
            const bf16x8 a = *(const bf16x8*)(ap + kk);
#pragma unroll
            for (int t = 0; t < 4; ++t) { const bf16x8 bq = *(const bf16x8*)(bp + (size_t)(16 * t) * K + kk); acc[t] = MFMA16(bq, a, acc[t]); }
        }
    }
}
__device__ __forceinline__ void sg_reduce(f32x4 (&acc)[4], LAS float* red, int wave, int lane) {
    if (wave > 0) {
#pragma unroll
        for (int t = 0; t < 4; ++t)
#pragma unroll
            for (int e = 0; e < 4; ++e) red[((wave - 1) * 16 + t * 4 + e) * 64 + lane] = acc[t][e];
    }
    __syncthreads();
    if (wave == 0) {
#pragma unroll
        for (int w = 0; w < 7; ++w)
#pragma unroll
            for (int t = 0; t < 4; ++t)
#pragma unroll
                for (int e = 0; e < 4; ++e) acc[t][e] += red[(w * 16 + t * 4 + e) * 64 + lane];
    }
    __syncthreads();
}
enum { SM_AB = 0, SM_OUT, SM_UP, SM_DOWN, SM_PLE };
__device__ __forceinline__ void sample_stage(const Params& P, LAS unsigned char* lds, int mode, int wv) {
    const int tid = ltid_w(wv), lane = tid & 63, wave = __builtin_amdgcn_readfirstlane(tid >> 6), fr = lane & 15, fq = lane >> 4;
    unsigned char* ws = lws(P);
    LAS float* red = (LAS float*)lds;
    const int ncb = mode == SM_UP ? 96 : 16, ntask = 16 * ncb;
    for (int task = lbid(); task < ntask; task += gridDim.x) {
        const int rb = task / ncb, cb = task - rb * ncb, row0 = rb * 16, col0 = cb * 64;
        f32x4 acc[4], acc2[4];
#pragma unroll
        for (int t = 0; t < 4; ++t) { acc[t] = (f32x4){0.f, 0.f, 0.f, 0.f}; acc2[t] = (f32x4){0.f, 0.f, 0.f, 0.f}; }
        if (mode == SM_AB) {
            sg_kloop(acc, (const bf16_t*)(ws + WS_Q) + (size_t)GROWS * 1024, (const bf16_t*)(ws + WS_WAT), 1024, row0, col0, wave, fr, fq);
            sg_kloop(acc2, (const bf16_t*)(ws + WS_Z) + (size_t)GROWS * 2048, (const bf16_t*)(ws + WS_WBT), 2048, row0, col0, wave, fr, fq);
        } else if (mode == SM_OUT) {
            sg_kloop(acc, (const bf16_t*)(ws + WS_H) + (size_t)GROWS * 1024, (const bf16_t*)(ws + WS_WOT), 1024, row0, col0, wave, fr, fq);
        } else if (mode == SM_UP) {
            sg_kloop(acc, (const bf16_t*)(ws + WS_XB) + (size_t)GROWS * 1024, (const bf16_t*)(ws + WS_WUT), 1024, row0, col0, wave, fr, fq);
        } else if (mode == SM_DOWN) {
            sg_kloop(acc, (const bf16_t*)(ws + WS_GA) + (size_t)GROWS * 3072, (const bf16_t*)(ws + WS_WDT), 3072, row0, col0, wave, fr, fq);
        } else {
            sg_kloop(acc, (const bf16_t*)(ws + WS_XB) + (size_t)GROWS * 1024, (const bf16_t*)(ws + WS_WGT), 1024, row0, col0, wave, fr, fq);
            sg_kloop(acc2, (const bf16_t*)(ws + WS_PE1) + (size_t)GROWS * 256, (const bf16_t*)(ws + WS_WPT), 256, row0, col0, wave, fr, fq);
        }
        sg_reduce(acc, red, wave, lane);
        if (mode == SM_AB || mode == SM_PLE) sg_reduce(acc2, red, wave, lane);
        if (wave == 0) {
            const int r = row0 + fr, lr = GROWS + r;
            float rs = 1.f;
            if (mode == SM_AB) { const f32x4* sp = (const f32x4*)((const float*)(ws + WS_SSQ) + (size_t)lr * 32); float s = 0.f;
#pragma unroll
                for (int q4 = 0; q4 < 8; ++q4) { const f32x4 x = sp[q4]; s += (x[0] + x[1]) + (x[2] + x[3]); }
                rs = rsqrtf(s * (1.f / 2048.f) + EPS); }
            if (mode == SM_UP || mode == SM_PLE) { const f32x4* sp = (const f32x4*)((const float*)(ws + WS_SSX) + (size_t)lr * 16); float s = 0.f;
#pragma unroll
                for (int q4 = 0; q4 < 4; ++q4) { const f32x4 x = sp[q4]; s += (x[0] + x[1]) + (x[2] + x[3]); }
                rs = rsqrtf(s * (1.f / 1024.f) + EPS); }
            float ss = 0.f;
#pragma unroll
            for (int t = 0; t < 4; ++t) {
                const int c = col0 + 16 * t + 4 * fq;
                if (mode == SM_AB) {
                    const u32x2 ga = *(const u32x2*)((const bf16_t*)(ws + WS_GT) + (size_t)lr * 2048 + c), gb = *(const u32x2*)((const bf16_t*)(ws + WS_GT) + (size_t)lr * 2048 + 1024 + c);
                    const float g0[4] = {bflo(ga.x), bfhi(ga.x), bflo(ga.y), bfhi(ga.y)}, g1[4] = {bflo(gb.x), bfhi(gb.x), bflo(gb.y), bfhi(gb.y)};
                    float v[4];
#pragma unroll
                    for (int e = 0; e < 4; ++e) v[e] = bf2f((bf16_t)(pk2(g0[e] * acc[t][e], 0.f) & 0xffffu)) + g1[e] * rs * acc2[t][e];
                    u32x2 w; w.x = pk2(v[0], v[1]); w.y = pk2(v[2], v[3]);
                    *(u32x2*)((bf16_t*)(ws + WS_H) + (size_t)lr * 1024 + c) = w;
                } else if (mode == SM_OUT || mode == SM_DOWN) {
                    bf16_t* xbp = (bf16_t*)(ws + WS_XB) + (size_t)lr * 1024 + c;
                    f32x4 x;
                    if (mode == SM_OUT) x = *(const f32x4*)(P.in[I_XS] + (size_t)r * DM + c);
                    else { const u32x2 xw = *(const u32x2*)xbp; x = (f32x4){bflo(xw.x), bfhi(xw.x), bflo(xw.y), bfhi(xw.y)}; }
                    const f32x4 v = (f32x4){x[0] + acc[t][0], x[1] + acc[t][1], x[2] + acc[t][2], x[3] + acc[t][3]};
                    u32x2 w; w.x = pk2(v[0], v[1]); w.y = pk2(v[2], v[3]);
                    *(u32x2*)xbp = w;
                    ss += (v[0] * v[0] + v[1] * v[1]) + (v[2] * v[2] + v[3] * v[3]);
                } else if (mode == SM_UP) {
                    const f32x4 v = acc[t] * rs;
                    u32x2 w; w.x = pk2(v[0], v[1]); w.y = pk2(v[2], v[3]);
                    *(u32x2*)((bf16_t*)(ws + WS_U) + (size_t)lr * 6144 + c) = w;
                    const int bq = r >> 5, tq = r & 31;
                    if (tq >= 30) *(f32x4*)(P.out + O_CFS + ((size_t)bq * 2 + (tq - 30)) * 6144 + c) = v;
                } else {
                    float* yr = P.out + O_YS + (size_t)r * DM + c;
                    const u32x2 xw = *(const u32x2*)((const bf16_t*)(ws + WS_XB) + (size_t)lr * 1024 + c);
                    const f32x4 x = (f32x4){bflo(xw.x), bfhi(xw.x), bflo(xw.y), bfhi(xw.y)};
                    f32x4 v;
#pragma unroll
                    for (int e = 0; e < 4; ++e) v[e] = x[e] + bf2f((bf16_t)(pk2(sigmoidf_(acc[t][e] * rs), 0.f) & 0xffffu)) * acc2[t][e];
                    *(f32x4*)yr = v;
                }
            }
            if (mode == SM_OUT || mode == SM_DOWN) {
                ss += __shfl_xor(ss, 16); ss += __shfl_xor(ss, 32);
                if (fq == 0) {
                    ((float*)(ws + WS_SSX))[(size_t)lr * 16 + cb] = ss;
                }
            }
        }
    }
    asm volatile("s_waitcnt vmcnt(0)" ::: "memory"); __syncthreads();
}

__device__ __forceinline__ float gelu_tanh(float x) { const float u = 0.7978845608028654f * (x + 0.044715f * x * x * x); return x * __builtin_amdgcn_rcpf(1.f + __builtin_amdgcn_exp2f(-2.f * LOG2E * u)); }
__device__ __forceinline__ void ew_phase(const Params& P, int g, int wv) {
    const size_t gt = (size_t)lbid() * 512 + ltid_w(wv), GT = (size_t)gridDim.x * 512;
    unsigned char* ws = lws(P);
    const bf16_t* ub = (const bf16_t*)(ws + WS_U); bf16_t* ga = (bf16_t*)(ws + WS_GA);
    const size_t n = (size_t)(grows(g) / 8) * 384;
    for (size_t i = gt; i < n; i += GT) {
        const int rg = (int)(i / 384), c0 = (int)(i % 384) * 8, lr0 = rg * 8;
        int t0, sb = 0; const bool smp = lr0 >= GROWS; if (smp) { sb = (lr0 - GROWS) >> 5; t0 = (lr0 - GROWS) & 31; } else t0 = lr0 & 2047;
        float w[2][4][8];
#pragma unroll
        for (int hf = 0; hf < 2; ++hf)
#pragma unroll
            for (int k = 0; k < 4; ++k) { const float* wp = (k < 3 ? P.in[I_FCW] + k * 6144 : P.in[I_FCB]) + hf * 3072 + c0; const f32x4 a = *(const f32x4*)wp, b2 = *(const f32x4*)(wp + 4);
                w[hf][k][0] = a[0]; w[hf][k][1] = a[1]; w[hf][k][2] = a[2]; w[hf][k][3] = a[3]; w[hf][k][4] = b2[0]; w[hf][k][5] = b2[1]; w[hf][k][6] = b2[2]; w[hf][k][7] = b2[3]; }
        float pa[2][8], pb[2][8];
#pragma unroll
        for (int hf = 0; hf < 2; ++hf) {
            const int ch = hf * 3072 + c0;
#pragma unroll
            for (int k = 0; k < 2; ++k) {
                float* dst = k == 0 ? pa[hf] : pb[hf];
                if (t0 > 0) unpack8(*(const u32x4*)(ub + (size_t)(lr0 - 2 + k) * 6144 + ch), dst);
                else if (smp) { const float* cp = P.in[I_CFFN] + ((size_t)sb * 2 + k) * 6144 + ch; const f32x4 a = *(const f32x4*)cp, b2 = *(const f32x4*)(cp + 4); dst[0] = a[0]; dst[1] = a[1]; dst[2] = a[2]; dst[3] = a[3]; dst[4] = b2[0]; dst[5] = b2[1]; dst[6] = b2[2]; dst[7] = b2[3]; }
                else {
#pragma unroll
                    for (int e = 0; e < 8; ++e) dst[e] = 0.f;
                }
            }
        }
#pragma unroll
        for (int r = 0; r < 8; ++r) {
            float cur[2][8], res[2][8];
#pragma unroll
            for (int hf = 0; hf < 2; ++hf) {
                unpack8(*(const u32x4*)(ub + (size_t)(lr0 + r) * 6144 + hf * 3072 + c0), cur[hf]);
#pragma unroll
                for (int e = 0; e < 8; ++e) { res[hf][e] = w[hf][3][e] + w[hf][0][e] * pa[hf][e] + w[hf][1][e] * pb[hf][e] + w[hf][2][e] * cur[hf][e]; pa[hf][e] = pb[hf][e]; pb[hf][e] = cur[hf][e]; }
            }
            float o[8];
#pragma unroll
            for (int e = 0; e < 8; ++e) o[e] = gelu_tanh(res[0][e]) * res[1][e];
            *(u32x4*)(ga + (size_t)(lr0 + r) * 3072 + c0) = pack8(o);
        }
    }
}

#define XB_TMO      128
#define XB_XCNT(j)  (256  + 64 * (j))
#define XB_XSUB(j)  (1280 + 64 * (j))
#define XB_XGEN(j)  (2304 + 64 * (j))
#define XB_TOP      3328
#define XB_TOPGEN   3392
#define XCD_BAR_WORDS 3456
#define XB_SPIN_CAP (1u << 18)

__device__ __forceinline__ unsigned xb_ld(unsigned* p)              { return __hip_atomic_load(p, __ATOMIC_RELAXED, __HIP_MEMORY_SCOPE_AGENT); }
__device__ __forceinline__ unsigned xb_add(unsigned* p, unsigned v) { return __hip_atomic_fetch_add(p, v, __ATOMIC_RELAXED, __HIP_MEMORY_SCOPE_AGENT); }
__device__ __forceinline__ unsigned xb_xcc_id() { return (unsigned)__builtin_amdgcn_s_getreg((3 << 11) | 20) & 0xFu; }
#define XB_SPIN(cond, bar) do { unsigned _sp = 0; while (cond) { __builtin_amdgcn_s_sleep(1); \
    if ((++_sp & 255u) == 0u) { if (xb_ld(&(bar)[XB_TMO])) break; if (_sp > XB_SPIN_CAP) { atomicAdd(&(bar)[XB_TMO], 1u); break; } } } } while (0)

struct XcdBarrier {
    unsigned* bar; unsigned x;
    volatile LAS unsigned* st;
};

__device__ __forceinline__ XcdBarrier xcd_barrier_post(unsigned* bar, volatile LAS unsigned* st, int tid_) {
    XcdBarrier b; b.bar = bar; b.x = xb_xcc_id(); b.st = st;
    if (tid_ == 0) (void)xb_add(&bar[XB_XCNT(b.x)], 1u);
    return b;
}
__device__ __forceinline__ void xcd_barrier_complete(unsigned* bar, unsigned x, unsigned& nloc, unsigned& nx) {
    const unsigned G = gridDim.x * gridDim.y * gridDim.z;
    unsigned sum, cnt, mine, sp = 0u;
    for (;;) {
        sum = 0u; cnt = 0u; mine = 0u;
#pragma unroll
        for (unsigned j = 0; j < 16; ++j) { const unsigned c = xb_ld(&bar[XB_XCNT(j)]); sum += c; cnt += (c > 0u) ? 1u : 0u; mine = (j == x) ? c : mine; }
        if (sum == G) break;
        __builtin_amdgcn_s_sleep(1);
        if ((++sp & 255u) == 0u) { if (xb_ld(&bar[XB_TMO])) break; if (sp > XB_SPIN_CAP) { atomicAdd(&bar[XB_TMO], 1u); break; } }
    }
    nloc = mine > 0u ? mine : 1u; nx = cnt > 0u ? cnt : 1u;
}

__device__ __forceinline__ void xcd_barrier(const XcdBarrier& b, int tid_) {
    asm volatile("s_waitcnt vmcnt(0)" ::: "memory");
    __syncthreads();
    if (tid_ == 0) {
        unsigned* bar = b.bar;
        __builtin_amdgcn_s_waitcnt(0);
        unsigned nloc = b.st[0], nx = b.st[1];
        if (nloc == 0u) { xcd_barrier_complete(bar, b.x, nloc, nx); b.st[0] = nloc; b.st[1] = nx; }
        const unsigned old = xb_add(&bar[XB_XSUB(b.x)], 1u);
        const unsigned gen = old / nloc;
        if (old + 1u == (gen + 1u) * nloc) {
            __builtin_amdgcn_fence(__ATOMIC_RELEASE, "agent");
            asm volatile("s_waitcnt vmcnt(0)" ::: "memory");
            const unsigned og = xb_add(&bar[XB_TOP], 1u);
            const unsigned tg = og / nx;
            if (og + 1u == (tg + 1u) * nx) xb_add(&bar[XB_TOPGEN], 1u);
            else XB_SPIN(xb_ld(&bar[XB_TOPGEN]) == tg, bar);
            __builtin_amdgcn_fence(__ATOMIC_ACQUIRE, "agent");
            xb_add(&bar[XB_XGEN(b.x)], 1u);
            asm volatile("s_waitcnt vmcnt(0)" ::: "memory");
        } else {
            XB_SPIN(xb_ld(&bar[XB_XGEN(b.x)]) == gen, bar);
            __builtin_amdgcn_fence(__ATOMIC_ACQUIRE, "agent");
            asm volatile("s_waitcnt vmcnt(0)" ::: "memory");
        }
    }
    __syncthreads();
}


constexpr int NPHASE = 19;
__device__ __forceinline__ void gbar(unsigned* ctr, unsigned target, int tid) {
    asm volatile("s_waitcnt vmcnt(0)" ::: "memory");
    __syncthreads();
    if (tid == 0) {
        __builtin_amdgcn_fence(__ATOMIC_RELEASE, "agent");
        asm volatile("s_waitcnt vmcnt(0)" ::: "memory");
        __hip_atomic_fetch_add(ctr, 1u, __ATOMIC_RELAXED, __HIP_MEMORY_SCOPE_AGENT);
        while (__hip_atomic_load(ctr, __ATOMIC_RELAXED, __HIP_MEMORY_SCOPE_AGENT) < target) __builtin_amdgcn_s_sleep(1);
        __builtin_amdgcn_fence(__ATOMIC_ACQUIRE, "agent");
        asm volatile("s_waitcnt vmcnt(0)" ::: "memory");
    }
    __syncthreads();
}
#define PH_IN(k) (P.ph_lo <= (k) && (k) < P.ph_hi)
#define PH_SYNC(k) do { if (PH_IN(k) && PH_IN((k) + 1)) { xcd_barrier(xbar, ltid_w(wv)); } } while (0)
#define WSB(off) ((const bf16_t*)(lws(P) + (off)))
#define GROUP_PHASES(g, base, M) \
    if (PH_IN(base + 0)) run_gemm(lds, P, M_IN, g, WSB(g == 0 ? WS_H : WS_H1), WSB(WS_W1T), M, NINP, 1024, wv); PH_SYNC(base + 0); \
    if (PH_IN(base + 1)) bc_prepass(P, g, wv); PH_SYNC(base + 1); \
    if (PH_IN(base + 2)) mixer_phase(P, lds, g, wv); PH_SYNC(base + 2); \
    if (PH_IN(base + 3)) { if (g == 1) sample_stage(P, lds, SM_AB, wv); run_gemm(lds, P, M_PA, g, WSB(WS_Q), WSB(WS_WAT), GROWS, 1024, 1024, wv); run_gemm(lds, P, M_PB, g, WSB(WS_Z), WSB(WS_WBT), GROWS, 1024, 2048, wv); } PH_SYNC(base + 3); \
    if (PH_IN(base + 4)) { if (g == 1) sample_stage(P, lds, SM_OUT, wv); run_gemm(lds, P, M_OUT, g, WSB(WS_H), WSB(WS_WOT), GROWS, 1024, 1024, wv); } PH_SYNC(base + 4); \
    if (PH_IN(base + 5)) { if (g == 1) sample_stage(P, lds, SM_UP, wv); run_gemm(lds, P, M_UP, g, WSB(WS_XB), WSB(WS_WUT), GROWS, 6144, 1024, wv); } PH_SYNC(base + 5); \
    if (PH_IN(base + 6)) ew_phase(P, g, wv); PH_SYNC(base + 6); \
    if (PH_IN(base + 7)) { if (g == 1) sample_stage(P, lds, SM_DOWN, wv); run_gemm(lds, P, M_DOWN, g, WSB(WS_GA), WSB(WS_WDT), GROWS, 1024, 3072, wv); } PH_SYNC(base + 7); \
    if (PH_IN(base + 8)) { if (g == 1) sample_stage(P, lds, SM_PLE, wv); run_gemm(lds, P, M_PG, g, WSB(WS_XB), WSB(WS_WGT), GROWS, 1024, 1024, wv); run_gemm(lds, P, M_PLE, g, WSB(g == 0 ? WS_PE : WS_PE1), WSB(WS_WPT), GROWS, 1024, 256, wv); }
__global__ void __launch_bounds__(512, 2) fwd_kernel(Params P) {
    extern __shared__ __attribute__((aligned(16))) unsigned char lds_raw[];
    LAS unsigned char* lds = (LAS unsigned char*)lds_raw;
    cg::grid_group grid = cg::this_grid();
    int wv = __builtin_amdgcn_readfirstlane(threadIdx.x >> 6); asm volatile("" : "+s"(wv));
    if (P.ph_hi - P.ph_lo > 1) grid.sync();
    volatile LAS unsigned* xst = (volatile LAS unsigned*)(lds + 157184);
    { const int t0_ = ltid_w(wv); if (t0_ < 2) xst[t0_] = 0u; __syncthreads(); }
    XcdBarrier xbar = xcd_barrier_post((unsigned*)(lws(P) + 1024), xst, ltid_w(wv));
    if (PH_IN(0)) { prologue(P, lds, wv); norm_pass(P, 0, wv); norm_pass(P, 1, wv); }
    PH_SYNC(0);
    GROUP_PHASES(0, 1, GROWS)
    PH_SYNC(9);
    GROUP_PHASES(1, 10, TMAX)
}

#ifndef MULTI_LAUNCH
#define MULTI_LAUNCH 0
#endif
#ifdef DBG_SRC
__global__ void dbg_dump(const unsigned short* src, float* dst, size_t n) { for (size_t i = (size_t)blockIdx.x * blockDim.x + threadIdx.x; i < n; i += (size_t)gridDim.x * blockDim.x) dst[i] = bf2f(src[i]); }
#endif
extern "C" void kernel_launch(void* const* d_in, const int* in_sizes, int n_in, void* d_out, int out_size, void* d_ws, size_t ws_size, hipStream_t stream) {
    static int grid = 0;
    if (grid == 0) {
        if (n_in != 32 || ws_size < WS_END) { fprintf(stderr, "kernel_launch: unexpected n_in %d / ws_size %zu (need %zu)\n", n_in, ws_size, (size_t)WS_END); grid = -1; return; }
        int dev = 0, cus = 0, per_cu = 0;
        hipGetDevice(&dev); hipDeviceGetAttribute(&cus, hipDeviceAttributeMultiprocessorCount, dev);
        if (hipFuncSetAttribute((const void*)fwd_kernel, hipFuncAttributeMaxDynamicSharedMemorySize, LDS_BYTES) != hipSuccess) { fprintf(stderr, "hipFuncSetAttribute failed\n"); grid = -1; return; }
        if (hipOccupancyMaxActiveBlocksPerMultiprocessor(&per_cu, (const void*)fwd_kernel, 512, LDS_BYTES) != hipSuccess || per_cu < 1) { fprintf(stderr, "occupancy query: %d\n", per_cu); per_cu = 1; }
        (void)hipGetLastError();
        grid = cus * per_cu;
    }
    if (grid < 0) return;
    Params p{};
    for (int i = 0; i < 32; ++i) p.in[i] = (const float*)d_in[i];
    p.out = (float*)d_out; p.ws = (unsigned char*)d_ws;
#if MULTI_LAUNCH
#ifndef DBG_HI
#define DBG_HI NPHASE
#endif
    for (int ph = 0; ph < DBG_HI; ++ph) { p.ph_lo = ph; p.ph_hi = ph + 1; hipLaunchKernelGGL(fwd_kernel, dim3(grid), dim3(512), LDS_BYTES, stream, p); }
#ifdef DBG_SRC
    hipLaunchKernelGGL(dbg_dump, dim3(2048), dim3(256), 0, stream, (const unsigned short*)((unsigned char*)d_ws + (DBG_SRC)), (float*)d_out, (size_t)(DBG_N));
#endif
#else
    p.ph_lo = 0; p.ph_hi = NPHASE;
    (void)hipMemsetAsync(d_ws, 0, 16384, stream);
    void* args[] = {&p};
    hipError_t e = hipLaunchCooperativeKernel((const void*)fwd_kernel, dim3(grid), dim3(512), args, LDS_BYTES, stream);
    if (e != hipSuccess) fprintf(stderr, "cooperative launch failed: %s (grid %d)\n", hipGetErrorString(e), grid);
#endif
}
```
